# Optimizing an MI355X kernel written in HIP

```python
import math
import jax, jax.numpy as jnp
from jax import lax
import numpy as np

D_MODEL = 4096
BATCH = 4
SEQ = 4096
DEPTH = 4

BRANCH_WIDTH = D_MODEL // 2
N_BRANCHES = 3
LRU_WIDTH = BRANCH_WIDTH
LRU_BLOCKS = 8
LRU_BLOCK = LRU_WIDTH // LRU_BLOCKS
LRU_CONV = 4
LRU_C = 8.0
ATTN_HEAD_DIM = 128
ATTN_HEADS = BRANCH_WIDTH // (2 * ATTN_HEAD_DIM)
ROPE_THETA = 10000.0
Q_BLOCK = 128
SCONV_WIDTH = BRANCH_WIDTH
SCONV_K = 3
N_BRANCH_SLICES = 10
IN_COLS = N_BRANCH_SLICES * BRANCH_WIDTH + N_BRANCHES * D_MODEL
NORM_EPS = 1e-6
SUBLN_EPS = 1e-5
POS_OFFSET_MAX = 1024

kernel_name = "hybrid_rglru_diffattn_shortconv_gated_parallel"


def _rmsnorm(x, w, eps=NORM_EPS):
    x32 = x.astype(jnp.float32)
    y = x32 * lax.rsqrt(jnp.mean(x32 * x32, axis=-1, keepdims=True) + eps)
    return (y * w.astype(jnp.float32)).astype(x.dtype)


def _causal_depthwise_conv(x, w):
    k_width = w.shape[0]
    s_len = x.shape[1]
    xp = jnp.pad(x, ((0, 0), (k_width - 1, 0), (0, 0)))
    y = xp[:, 0:s_len] * w[0]
    for j in range(1, k_width):
        y = y + xp[:, j:j + s_len] * w[j]
    return y


def _lin_combine(c1, c2):
    a1, b1 = c1
    a2, b2 = c2
    return a1 * a2, a2 * b1 + b2


def _rglru_branch(xa, conv_w, conv_b, w_rg, b_rg, w_ig, b_ig, lru_lambda):
    xc = _causal_depthwise_conv(xa, conv_w) + conv_b
    b_, s_, _ = xc.shape
    xb = xc.reshape(b_, s_, LRU_BLOCKS, LRU_BLOCK)
    r = jax.nn.sigmoid(jnp.einsum('bsnc,ncd->bsnd', xb, w_rg).reshape(b_, s_, LRU_WIDTH) + b_rg)
    i = jax.nn.sigmoid(jnp.einsum('bsnc,ncd->bsnd', xb, w_ig).reshape(b_, s_, LRU_WIDTH) + b_ig)
    log_a = LRU_C * r.astype(jnp.float32) * jax.nn.log_sigmoid(lru_lambda.astype(jnp.float32))
    a = jnp.exp(log_a)
    mult = jnp.sqrt(-jnp.expm1(2.0 * log_a))
    u = xc.astype(jnp.float32) * i.astype(jnp.float32) * mult
    _, h = lax.associative_scan(_lin_combine, (a, u), axis=1)
    return h.astype(xa.dtype)


def _rope(t, positions):
    half = ATTN_HEAD_DIM // 2
    inv_freq = ROPE_THETA ** (-jnp.arange(0, half, dtype=jnp.float32) * (2.0 / ATTN_HEAD_DIM))
    ang = positions.astype(jnp.float32)[..., None] * inv_freq
    cos = jnp.cos(ang)[:, :, None, None, :]
    sin = jnp.sin(ang)[:, :, None, None, :]
    t32 = t.astype(jnp.float32)
    t1, t2 = t32[..., :half], t32[..., half:]
    out = jnp.concatenate([t1 * cos - t2 * sin, t2 * cos + t1 * sin], axis=-1)
    return out.astype(t.dtype)


def _diff_attention(q, k, v, positions, lam_q1, lam_k1, lam_q2, lam_k2, subln_w, lam_init):
    b_, s_, _ = q.shape
    q = _rope(q.reshape(b_, s_, ATTN_HEADS, 2, ATTN_HEAD_DIM), positions)
    k = _rope(k.reshape(b_, s_, ATTN_HEADS, 2, ATTN_HEAD_DIM), positions)
    v = v.reshape(b_, s_, ATTN_HEADS, 2 * ATTN_HEAD_DIM)
    lam = (jnp.exp(jnp.sum(lam_q1.astype(jnp.float32) * lam_k1.astype(jnp.float32)))
           - jnp.exp(jnp.sum(lam_q2.astype(jnp.float32) * lam_k2.astype(jnp.float32)))
           + lam_init)
    scale = ATTN_HEAD_DIM ** -0.5
    outs = []
    for blk in range(s_ // Q_BLOCK):
        start = blk * Q_BLOCK
        end = start + Q_BLOCK
        qb = q[:, start:end]
        kb = k[:, :end]
        vb = v[:, :end]
        s = jnp.einsum('bqhcd,bkhcd->bhcqk', qb, kb).astype(jnp.float32) * scale
        mask = jnp.arange(end)[None, :] <= (start + jnp.arange(Q_BLOCK))[:, None]
        s = jnp.where(mask, s, -jnp.inf)
        p = jax.nn.softmax(s, axis=-1)
        pd = p[:, :, 0] - lam * p[:, :, 1]
        outs.append(jnp.einsum('bhqk,bkhe->bqhe', pd.astype(v.dtype), vb))
    o = jnp.concatenate(outs, axis=1)
    o = _rmsnorm(o, subln_w, SUBLN_EPS) * (1.0 - lam_init)
    return o.reshape(b_, s_, ATTN_HEADS * 2 * ATTN_HEAD_DIM)


def _short_conv_branch(cb, cc, cx, conv_w):
    return cb * _causal_depthwise_conv(cc * cx, conv_w)


def _layer(x, positions, layer_idx, norm_w, w_in, gate_b, conv_a_w, conv_a_b, w_rg, b_rg,
           w_ig, b_ig, lru_lambda, lam_q1, lam_k1, lam_q2, lam_k2, subln_w, conv_c_w,
           w_branch, w_out):
    b_, s_, _ = x.shape
    h = _rmsnorm(x, norm_w)
    proj = jnp.einsum('bsd,de->bse', h, w_in)
    split_points = [BRANCH_WIDTH * (j + 1) for j in range(N_BRANCH_SLICES)]
    (ax, ag, q, k, v, bg, cb, cc, cx, cg, gl) = jnp.split(proj, split_points, axis=-1)
    lam_init = 0.8 - 0.6 * math.exp(-0.3 * layer_idx)
    ya = _rglru_branch(ax, conv_a_w, conv_a_b, w_rg, b_rg, w_ig, b_ig, lru_lambda) * jax.nn.silu(ag)
    yb = _diff_attention(q, k, v, positions, lam_q1, lam_k1, lam_q2, lam_k2, subln_w, lam_init) * jax.nn.silu(bg)
    yc = _short_conv_branch(cb, cc, cx, conv_c_w) * jax.nn.silu(cg)
    gates = jax.nn.sigmoid(gl.reshape(b_, s_, N_BRANCHES, D_MODEL) + gate_b)
    merged = (gates[:, :, 0] * jnp.einsum('bsw,wd->bsd', ya, w_branch[0])
              + gates[:, :, 1] * jnp.einsum('bsw,wd->bsd', yb, w_branch[1])
              + gates[:, :, 2] * jnp.einsum('bsw,wd->bsd', yc, w_branch[2]))
    return x + jnp.einsum('bsd,de->bse', merged, w_out)


def setup_inputs(seed: int = 0) -> dict:
    key = jax.random.key(seed)
    ks = jax.random.split(key, 24)
    f32 = jnp.float32
    x = jax.random.normal(ks[0], (BATCH, SEQ, D_MODEL), f32)
    offs = jax.random.randint(ks[1], (BATCH, 1), 0, POS_OFFSET_MAX, dtype=jnp.int32)
    positions = (offs + jnp.arange(SEQ, dtype=jnp.int32)[None, :]).astype(jnp.int32)
    norm_w = 1.0 + 0.02 * jax.random.normal(ks[2], (DEPTH, D_MODEL), f32)
    w_in = jax.random.normal(ks[3], (DEPTH, D_MODEL, IN_COLS), f32) * D_MODEL ** -0.5
    gate_b = 0.02 * jax.random.normal(ks[4], (DEPTH, N_BRANCHES, D_MODEL), f32)
    conv_a_w = jax.random.normal(ks[5], (DEPTH, LRU_CONV, LRU_WIDTH), f32) * LRU_CONV ** -0.5
    conv_a_b = 0.02 * jax.random.normal(ks[6], (DEPTH, LRU_WIDTH), f32)
    w_rg = jax.random.normal(ks[7], (DEPTH, LRU_BLOCKS, LRU_BLOCK, LRU_BLOCK), f32) * LRU_BLOCK ** -0.5
    b_rg = 0.02 * jax.random.normal(ks[8], (DEPTH, LRU_WIDTH), f32)
    w_ig = jax.random.normal(ks[9], (DEPTH, LRU_BLOCKS, LRU_BLOCK, LRU_BLOCK), f32) * LRU_BLOCK ** -0.5
    b_ig = 0.02 * jax.random.normal(ks[10], (DEPTH, LRU_WIDTH), f32)
    a_c = jax.random.uniform(ks[11], (DEPTH, LRU_WIDTH), f32, 0.9, 0.999)
    s_base = a_c ** (1.0 / LRU_C)
    lru_lambda = jnp.log(s_base) - jnp.log1p(-s_base)
    lam_q1 = 0.1 * jax.random.normal(ks[12], (DEPTH, ATTN_HEAD_DIM), f32)
    lam_k1 = 0.1 * jax.random.normal(ks[13], (DEPTH, ATTN_HEAD_DIM), f32)
    lam_q2 = 0.1 * jax.random.normal(ks[14], (DEPTH, ATTN_HEAD_DIM), f32)
    lam_k2 = 0.1 * jax.random.normal(ks[15], (DEPTH, ATTN_HEAD_DIM), f32)
    subln_w = 1.0 + 0.02 * jax.random.normal(ks[16], (DEPTH, 2 * ATTN_HEAD_DIM), f32)
    conv_c_w = jax.random.normal(ks[17], (DEPTH, SCONV_K, SCONV_WIDTH), f32) * SCONV_K ** -0.5
    w_branch = jax.random.normal(ks[18], (DEPTH, N_BRANCHES, BRANCH_WIDTH, D_MODEL), f32) * BRANCH_WIDTH ** -0.5
    w_out = jax.random.normal(ks[19], (DEPTH, D_MODEL, D_MODEL), f32) * D_MODEL ** -0.5
    final_norm_w = 1.0 + 0.02 * jax.random.normal(ks[20], (D_MODEL,), f32)
    return {"x": x, "positions": positions, "norm_w": norm_w, "w_in": w_in, "gate_b": gate_b,
            "conv_a_w": conv_a_w, "conv_a_b": conv_a_b, "w_rg": w_rg, "b_rg": b_rg,
            "w_ig": w_ig, "b_ig": b_ig, "lru_lambda": lru_lambda, "lam_q1": lam_q1,
            "lam_k1": lam_k1, "lam_q2": lam_q2, "lam_k2": lam_k2, "subln_w": subln_w,
            "conv_c_w": conv_c_w, "w_branch": w_branch, "w_out": w_out,
            "final_norm_w": final_norm_w}


def reference(x, positions, norm_w, w_in, gate_b, conv_a_w, conv_a_b, w_rg, b_rg, w_ig, b_ig,
              lru_lambda, lam_q1, lam_k1, lam_q2, lam_k2, subln_w, conv_c_w, w_branch, w_out,
              final_norm_w):
    for l in range(DEPTH):
        x = _layer(x, positions, l, norm_w[l], w_in[l], gate_b[l], conv_a_w[l], conv_a_b[l],
                   w_rg[l], b_rg[l], w_ig[l], b_ig[l], lru_lambda[l], lam_q1[l], lam_k1[l],
                   lam_q2[l], lam_k2[l], subln_w[l], conv_c_w[l], w_branch[l], w_out[l])
    return _rmsnorm(x, final_norm_w)
```

```cpp
#include <hip/hip_runtime.h>
#include <cstdio>
#include <cstdint>

#ifndef MK_N_LAUNCHES
#define MK_N_LAUNCHES 1
#endif
#ifndef MK_DBG
#define MK_DBG 0
#endif
#ifndef PH_MASK
#define PH_MASK 0xFFFF
#endif
#define PH_ON(b) ((PH_MASK >> (b)) & 1)
#ifndef DUP_MASK
#define DUP_MASK 0
#endif
#ifndef WG_P
#define WG_P 4
#endif
#ifndef WG_Q
#define WG_Q 4
#endif
#ifndef WG_B
#define WG_B 4
#endif
#ifndef WG_O
#define WG_O 4
#endif
#define PH_REP(b) (1 + ((DUP_MASK >> (b)) & 1))

#define LAS __attribute__((address_space(3)))
#define GAS __attribute__((address_space(1)))
typedef unsigned short bf16_t;
typedef short bf16x8 __attribute__((ext_vector_type(8)));
typedef short s16x4 __attribute__((ext_vector_type(4)));
typedef float f32x4 __attribute__((ext_vector_type(4)));
typedef float f32x16 __attribute__((ext_vector_type(16)));
typedef unsigned u32x4 __attribute__((ext_vector_type(4)));
typedef unsigned u32x2 __attribute__((ext_vector_type(2)));
typedef float f32x2 __attribute__((ext_vector_type(2)));
typedef int i32x4 __attribute__((ext_vector_type(4)));

constexpr int DM = 4096, NBATCH = 4, SEQ = 4096, DEPTH = 4, MTOK = NBATCH * SEQ;
constexpr int BW = 2048, INC = 32768;
constexpr int COL_AX = 0, COL_AG = 2048, COL_Q = 4096, COL_K = 6144, COL_V = 8192, COL_BG = 10240, COL_CB = 12288, COL_CC = 14336, COL_CX = 16384, COL_CG = 18432, COL_GL = 20480;
constexpr int YW = 3 * BW;
constexpr int PP = 2048; constexpr size_t PLANE = (size_t)MTOK * PP;
#define PLO(col) ((size_t)((col) >> 11) * PLANE)
constexpr int NGATE = 3 * DM;
constexpr int NQ_TILES = 104, NB_TILES = INC / 256 - NQ_TILES;
__host__ __device__ constexpr int q_tile(int q) { return q < 40 ? 8 + q : 24 + q; }
__host__ __device__ constexpr int b_tile(int p) { return p < 8 ? p : p + 40; }
constexpr int CHUNK = 128, NCHUNK = SEQ / CHUNK;

__device__ __forceinline__ unsigned cvt_pk_bf16(float lo, float hi) { unsigned r; asm volatile("v_cvt_pk_bf16_f32 %0, %1, %2" : "=v"(r) : "v"(lo), "v"(hi)); return r; }
__device__ __forceinline__ float bf_lo(unsigned w) { return __uint_as_float(w << 16); }
__device__ __forceinline__ float bf_hi(unsigned w) { return __uint_as_float(w & 0xffff0000u); }
__device__ __forceinline__ float bf2f(bf16_t b) { return __uint_as_float(((unsigned)b) << 16); }
__device__ __forceinline__ void unpack8(const u32x4 w, float (&f)[8]) { f[0] = bf_lo(w.x); f[1] = bf_hi(w.x); f[2] = bf_lo(w.y); f[3] = bf_hi(w.y); f[4] = bf_lo(w.z); f[5] = bf_hi(w.z); f[6] = bf_lo(w.w); f[7] = bf_hi(w.w); }
__device__ __forceinline__ u32x4 pack8f(const float (&f)[8]) { u32x4 w; w.x = cvt_pk_bf16(f[0], f[1]); w.y = cvt_pk_bf16(f[2], f[3]); w.z = cvt_pk_bf16(f[4], f[5]); w.w = cvt_pk_bf16(f[6], f[7]); return w; }
__device__ __forceinline__ float fast_sigmoid(float x) { return __builtin_amdgcn_rcpf(1.0f + __builtin_amdgcn_exp2f(-1.4426950408889634f * x)); }
__device__ __forceinline__ float fast_silu(float x) { return x * fast_sigmoid(x); }
__device__ __forceinline__ float wave_sum(float v) {
#pragma unroll
    for (int o = 1; o < 64; o <<= 1) v += __shfl_xor(v, o);
    return v;
}
__device__ __forceinline__ float one_minus_a2(float L2) {
    const float y = 1.3862943611198906f * L2;
    if (y > -0.1f) { float p = 1.0f / 120.0f; p = p * y + 1.0f / 24.0f; p = p * y + 1.0f / 6.0f; p = p * y + 0.5f; p = p * y + 1.0f; return -y * p; }
    return 1.0f - __builtin_amdgcn_exp2f(2.0f * L2);
}

__device__ __forceinline__ int fresh_lane() { int l; asm volatile("v_mbcnt_lo_u32_b32 %0, -1, 0\n\tv_mbcnt_hi_u32_b32 %0, -1, %0" : "=v"(l)); return l; }

namespace pg8 {
constexpr int BM = 256, BK = 64, HALF = 128, HTB = HALF * BK * 2, STAGE_BYTES = 8 * HTB, NXCD = 8, WGM = 4;
__host__ __device__ __forceinline__ int lds_byte(int r, int c) { const int st = (r >> 4) * 2 + (c >> 5), rr = r & 15, cc = c & 31, ob = rr * 64 + cc * 2; return st * 1024 + (ob ^ (((ob >> 9) & 1) << 5)); }
__host__ __device__ __forceinline__ void stage_rc(int b, int& R, int& C) { const int st = b / 1024, sb = b % 1024, swz = sb ^ (((sb >> 9) & 1) << 5); R = (st >> 1) * 16 + swz / 64; C = (st & 1) * 32 + (swz % 64) / 2; }
__host__ __device__ __forceinline__ int perm32(int rho) { const int n = rho >> 4, i = rho & 15; return 8 * (i >> 2) + 4 * n + (i & 3); }

struct Unit { int pm, pn, ka, kb, j; };
struct Gemm { const bf16_t* A; const bf16_t* Bt; int lda, ldb, K; };

template <int MODE, int WG = WGM> struct Order {
    int nM, nN, nwg, G, c;
    __device__ void init(int Mr, int N, int G_, int c_) { nM = Mr / BM; nN = N / BM; nwg = nM * nN; G = G_; c = c_; }
    __device__ bool next(int i, Unit& u) const {
        const int it = (MODE == 2) ? i / 3 : i; const int j = (MODE == 2) ? i - 3 * it : 0;
        const long L = (long)it * G + c; if (L >= nwg) return false;
        int wgid = (int)L; { const int q = nwg / NXCD, r = nwg % NXCD, xcd = wgid % NXCD, off = wgid / NXCD; wgid = (xcd < r ? xcd * (q + 1) : r * (q + 1) + (xcd - r) * q) + off; }
        const int nig = WG * nN, gid = wgid / nig, fm = gid * WG, gsz = (nM - fm) < WG ? (nM - fm) : WG;
        u.pm = fm + ((wgid % nig) % gsz); u.pn = (wgid % nig) / gsz; u.j = j;
        if (MODE == 1) { u.ka = (u.pn >> 1) * 256; u.kb = 0; }
        else if (MODE == 2) { u.ka = j * BW; u.kb = j * BW; }
        else { u.ka = 0; u.kb = 0; }
        if (MODE == 3) u.pn = q_tile(u.pn); else if (MODE == 4) u.pn = b_tile(u.pn);
        return true;
    }
};

template <bool I8> struct AccT { typedef f32x4 type; };
template <> struct AccT<true> { typedef i32x4 type; };
template <class Epi, class Sched, bool ALIGN_EPI = true, bool SP2 = true, bool I8 = false>
__device__ __forceinline__ void gemm_phase(LAS unsigned char* lds, const Gemm g, const Sched& S, const Epi& E) {
    const int wid = __builtin_amdgcn_readfirstlane(threadIdx.x >> 6), lane = fresh_lane(), tid = wid * 64 + lane, wr = wid >> 2, wc = wid & 3, fr = lane & 15, fq = lane >> 4;
    const int K = g.K, nt = K / BK;
    unsigned voffA[2], voffB[2];
#pragma unroll
    for (int i = 0; i < 2; ++i) { int R, C; stage_rc(tid * 16 + i * 8192, R, C);
        int Rb;
        if (Epi::BPERM == 0) Rb = R; else if (Epi::BPERM == 1) Rb = (R & ~31) + perm32(R & 31); else Rb = (R >> 6) * 128 + ((R >> 5) & 1) * 32 + perm32(R & 31);
        voffA[i] = (unsigned)(R * g.lda + C) * 2u; voffB[i] = (unsigned)(Rb * g.ldb + C) * 2u; }
    const size_t kstep = (size_t)(BK * 2);
    const size_t hstepA = (size_t)HALF * g.lda * 2, hstepB = (size_t)(Epi::BPERM == 2 ? 64 : HALF) * g.ldb * 2;
    const size_t tstepA = (size_t)BM * g.lda * 2, tstepB = (size_t)BM * g.ldb * 2;
    const unsigned ldsw = (unsigned)wid * 1024u;
    const int aoff = lds_byte(wr * 64 + fr, fq * 8), boff = lds_byte(wc * 32 + fr, fq * 8);
#define PG8_SA(b, h) (((b) * 2 + (h)) * HTB)
#define PG8_SB(b, h) ((4 + (b) * 2 + (h)) * HTB)
#define PG8_STAGE(bufoff, gbase, voff) do { _Pragma("unroll") for (int _i = 0; _i < 2; ++_i) \
        __builtin_amdgcn_global_load_lds((const unsigned*)((const char*)(gbase) + (voff)[_i]), (LAS unsigned*)(lds + (bufoff) + ldsw + _i * 8192), 16, 0, 0); } while (0)
#define PG8_LDA(dst, b, h) do { _Pragma("unroll") for (int m = 0; m < 4; ++m) _Pragma("unroll") for (int k = 0; k < 2; ++k) dst[m][k] = *(const LAS bf16x8*)(lds + PG8_SA(b, h) + aoff + m * 2048 + k * 1024); } while (0)
#define PG8_LDB(dst, b, h) do { _Pragma("unroll") for (int n = 0; n < 2; ++n) _Pragma("unroll") for (int k = 0; k < 2; ++k) dst[n][k] = *(const LAS bf16x8*)(lds + PG8_SB(b, h) + boff + n * 2048 + k * 1024); } while (0)
#define PG8_MMA(ai, bj, At, Bt) do { __builtin_amdgcn_s_setprio(1); \
        if constexpr (I8) { _Pragma("unroll") for (int k = 0; k < 2; ++k) _Pragma("unroll") for (int m = 0; m < 4; ++m) _Pragma("unroll") for (int n = 0; n < 2; ++n)     \
            acc[ai][bj][m][n] = __builtin_amdgcn_mfma_i32_16x16x64_i8(__builtin_bit_cast(i32x4, Bt[n][k]), __builtin_bit_cast(i32x4, At[m][k]), acc[ai][bj][m][n], 0, 0, 0); } \
        else { _Pragma("unroll") for (int m = 0; m < 4; ++m) _Pragma("unroll") for (int n = 0; n < 2; ++n) _Pragma("unroll") for (int k = 0; k < 2; ++k) \
            acc[ai][bj][m][n] = __builtin_amdgcn_mfma_f32_16x16x32_bf16(Bt[n][k], At[m][k], acc[ai][bj][m][n], 0, 0, 0); } \
        __builtin_amdgcn_s_setprio(0); } while (0)
#define PG8_WAIT_V(n) asm volatile("s_waitcnt vmcnt(" #n ")" ::: "memory")
#define PG8_WAIT_L(n) asm volatile("s_waitcnt lgkmcnt(" #n ")" ::: "memory")
#define PG8_BAR __builtin_amdgcn_s_barrier()
#define PG8_SCHED __builtin_amdgcn_sched_barrier(0)
    Unit cur, nxt; int ui = 0;
    if (!S.next(0, cur)) return;
    typedef typename AccT<I8>::type acc_t;
    acc_t acc[2][2][4][2];
#pragma unroll
    for (int a = 0; a < 2; ++a)
#pragma unroll
        for (int b = 0; b < 2; ++b)
#pragma unroll
            for (int m = 0; m < 4; ++m)
#pragma unroll
                for (int n = 0; n < 2; ++n) acc[a][b][m][n] = (acc_t){0, 0, 0, 0};
    bf16x8 At[4][2], B0[2][2], B1[2][2];
    const char* cA = (const char*)g.A + (size_t)cur.pm * tstepA + (size_t)cur.ka * 2; const char* cB = (const char*)g.Bt + (size_t)cur.pn * tstepB + (size_t)cur.kb * 2;
    if constexpr (SP2) {
        PG8_STAGE(PG8_SB(0, 0), cB, voffB); PG8_STAGE(PG8_SB(0, 1), cB + hstepB, voffB); PG8_STAGE(PG8_SA(0, 0), cA, voffA); PG8_STAGE(PG8_SA(0, 1), cA + hstepA, voffA);
        if (wr == 1) PG8_BAR;
        PG8_WAIT_V(2); PG8_BAR;
        PG8_STAGE(PG8_SB(1, 0), cB + kstep, voffB); PG8_STAGE(PG8_SA(1, 0), cA + kstep, voffA); PG8_STAGE(PG8_SB(1, 1), cB + hstepB + kstep, voffB);
        PG8_WAIT_V(6); PG8_BAR;
    } else {
        PG8_STAGE(PG8_SB(0, 0), cB, voffB); PG8_STAGE(PG8_SA(0, 0), cA, voffA); PG8_STAGE(PG8_SB(0, 1), cB + hstepB, voffB); PG8_STAGE(PG8_SA(0, 1), cA + hstepA, voffA);
        if (wr == 1) PG8_BAR;
        PG8_WAIT_V(4); PG8_BAR;
        PG8_STAGE(PG8_SB(1, 0), cB + kstep, voffB); PG8_STAGE(PG8_SA(1, 0), cA + kstep, voffA); PG8_STAGE(PG8_SB(1, 1), cB + hstepB + kstep, voffB);
        PG8_WAIT_V(6); PG8_BAR;
    }
    for (;;) {
        const bool has_next = S.next(ui + 1, nxt);
        const char* nA = has_next ? (const char*)g.A + (size_t)nxt.pm * tstepA + (size_t)nxt.ka * 2 : cA; const char* nB = has_next ? (const char*)g.Bt + (size_t)nxt.pn * tstepB + (size_t)nxt.kb * 2 : cB;
#pragma unroll 1
        for (int t = 0; t < nt; t += 2) {
            const bool last = (t == nt - 2);
            const char* a1 = cA + (size_t)(t + 1) * kstep;
            const char* a2 = last ? nA : cA + (size_t)(t + 2) * kstep; const char* b2 = last ? nB : cB + (size_t)(t + 2) * kstep;
            const char* a3 = a2 + kstep; const char* b3 = b2 + kstep;
            if constexpr (SP2) {
            PG8_LDB(B0, 0, 0); PG8_LDB(B1, 0, 1); PG8_SCHED; PG8_LDA(At, 0, 0); PG8_STAGE(PG8_SA(1, 1), a1 + hstepA, voffA);
            PG8_WAIT_V(8); PG8_WAIT_L(0); PG8_BAR; PG8_MMA(0, 0, At, B0); PG8_MMA(0, 1, At, B1); PG8_BAR; PG8_SCHED;
            PG8_LDA(At, 0, 1); PG8_STAGE(PG8_SB(0, 0), b2, voffB); PG8_STAGE(PG8_SB(0, 1), b2 + hstepB, voffB); PG8_STAGE(PG8_SA(0, 0), a2, voffA);
            PG8_WAIT_V(8); PG8_WAIT_L(0); PG8_BAR; PG8_MMA(1, 0, At, B0); PG8_MMA(1, 1, At, B1); PG8_BAR; PG8_SCHED;
            PG8_LDB(B0, 1, 0); PG8_LDB(B1, 1, 1); PG8_SCHED; PG8_LDA(At, 1, 0); PG8_STAGE(PG8_SA(0, 1), a2 + hstepA, voffA);
            PG8_WAIT_V(8); PG8_WAIT_L(0); PG8_BAR; PG8_MMA(0, 0, At, B0); PG8_MMA(0, 1, At, B1); PG8_BAR; PG8_SCHED;
            PG8_LDA(At, 1, 1); PG8_STAGE(PG8_SB(1, 0), b3, voffB); PG8_STAGE(PG8_SB(1, 1), b3 + hstepB, voffB); PG8_STAGE(PG8_SA(1, 0), a3, voffA);
            PG8_WAIT_V(8); PG8_WAIT_L(0); PG8_BAR; PG8_MMA(1, 0, At, B0); PG8_MMA(1, 1, At, B1); PG8_BAR; PG8_SCHED;
            } else {
            PG8_LDB(B0, 0, 0); PG8_SCHED; PG8_LDA(At, 0, 0); PG8_STAGE(PG8_SA(1, 1), a1 + hstepA, voffA);
            PG8_WAIT_L(8); PG8_BAR; PG8_WAIT_L(0); PG8_MMA(0, 0, At, B0); PG8_BAR; PG8_SCHED;
            PG8_LDB(B1, 0, 1); PG8_STAGE(PG8_SB(0, 0), b2, voffB);
            PG8_BAR; PG8_WAIT_L(0); PG8_MMA(0, 1, At, B1); PG8_BAR;
            PG8_LDA(At, 0, 1); PG8_STAGE(PG8_SA(0, 0), a2, voffA);
            PG8_BAR; PG8_WAIT_L(0); PG8_MMA(1, 0, At, B0); PG8_BAR; PG8_SCHED;
            PG8_STAGE(PG8_SB(0, 1), b2 + hstepB, voffB);
            PG8_WAIT_V(6); PG8_BAR; PG8_MMA(1, 1, At, B1); PG8_BAR;
            PG8_LDB(B0, 1, 0); PG8_SCHED; PG8_LDA(At, 1, 0); PG8_STAGE(PG8_SA(0, 1), a2 + hstepA, voffA);
            PG8_WAIT_L(8); PG8_BAR; PG8_WAIT_L(0); PG8_MMA(0, 0, At, B0); PG8_BAR; PG8_SCHED;
            PG8_LDB(B1, 1, 1); PG8_STAGE(PG8_SB(1, 0), b3, voffB);
            PG8_BAR; PG8_WAIT_L(0); PG8_MMA(0, 1, At, B1); PG8_BAR;
            PG8_LDA(At, 1, 1); PG8_STAGE(PG8_SA(1, 0), a3, voffA);
            PG8_BAR; PG8_WAIT_L(0); PG8_MMA(1, 0, At, B0); PG8_BAR; PG8_SCHED;
            PG8_STAGE(PG8_SB(1, 1), b3 + hstepB, voffB);
            PG8_WAIT_V(6); PG8_BAR; PG8_MMA(1, 1, At, B1); PG8_BAR;
            }
        }
        if constexpr (ALIGN_EPI) { if (wr == 0) PG8_BAR; }
        const int lz = fresh_lane();
        const bool fin = E(acc, cur, wr, wc, lz & 15, lz >> 4);
        if (!has_next) break;
        if (fin) {
#pragma unroll
        for (int a = 0; a < 2; ++a)
#pragma unroll
            for (int b = 0; b < 2; ++b)
#pragma unroll
                for (int m = 0; m < 4; ++m)
#pragma unroll
                    for (int n = 0; n < 2; ++n) acc[a][b][m][n] = (acc_t){0, 0, 0, 0};
        }
        cur = nxt; cA = nA; cB = nB; ++ui;
        if constexpr (ALIGN_EPI) { if (wr == 1) PG8_BAR; }
    }
    PG8_WAIT_V(0);
    if constexpr (!ALIGN_EPI) { if (wr == 0) PG8_BAR; }
    PG8_BAR;
#undef PG8_SA
#undef PG8_SB
#undef PG8_STAGE
#undef PG8_LDA
#undef PG8_LDB
#undef PG8_MMA
#undef PG8_WAIT_V
#undef PG8_WAIT_L
#undef PG8_BAR
#undef PG8_SCHED
}

template <class T> __device__ __forceinline__ T ldu(const void* ubase, unsigned voff) { return *(const T*)((const char*)ubase + voff); }
template <class T> __device__ __forceinline__ void stu(void* ubase, unsigned voff, T v) { *(T*)((char*)ubase + voff) = v; }
template <class T> __device__ __forceinline__ void stu_nt(void* ubase, unsigned voff, T v) { __builtin_nontemporal_store(v, (T*)((char*)ubase + voff)); }
__device__ __forceinline__ f32x4 tof(f32x4 a) { return a; }
__device__ __forceinline__ f32x4 tof(i32x4 a) { return __builtin_convertvector(a, f32x4); }
struct EpiProj {
    static constexpr int BPERM = 2;
    bf16_t* P; const float* gate_b; const int* pos; const float* sa; const float* sw;
    template <class AccV> __device__ __forceinline__ bool operator()(AccV (&acc)[2][2][4][2], const Unit& u, int wr, int wc, int fr, int fq) const {
        const int rowu = u.pm * BM + wr * 64;
        const int dlu = (wc & 1) * 32;
        const int cbu = u.pn * BM + (wc >> 1) * 128 + dlu;
        const unsigned vP = (unsigned)(fr * PP + 8 * fq) * 2u;
        const int pn = u.pn;
        f32x4 sv[2][2]; float sr[2][4];
#pragma unroll
        for (int bj = 0; bj < 2; ++bj)
#pragma unroll
            for (int n = 0; n < 2; ++n) sv[bj][n] = sw ? ldu<f32x4>(sw + cbu + bj * 64 + 4 * n, (unsigned)(8 * fq) * 4u) : (f32x4){1.f, 1.f, 1.f, 1.f};
#pragma unroll
        for (int ai = 0; ai < 2; ++ai)
#pragma unroll
            for (int m = 0; m < 4; ++m) sr[ai][m] = sa ? ldu<float>(sa + rowu + ai * HALF + m * 16, (unsigned)fr * 4u) : 1.f;
        if (pn >= 16 && pn < 32) {
            float fsc[8];
#pragma unroll
            for (int q = 0; q < 8; ++q) fsc[q] = __builtin_amdgcn_exp2f(-(float)(dlu + 8 * fq + q) * 0.20762050593046014f - 2.651496129472319f);
            float posf[2][4];
#pragma unroll
            for (int ai = 0; ai < 2; ++ai)
#pragma unroll
                for (int m = 0; m < 4; ++m) posf[ai][m] = (float)ldu<int>(pos + rowu + ai * HALF + m * 16, (unsigned)fr * 4u);
#pragma unroll
            for (int ai = 0; ai < 2; ++ai)
#pragma unroll
                for (int m = 0; m < 4; ++m) { const int row = rowu + ai * HALF + m * 16;
                    f32x4 c0, c1, s0, s1;
#pragma unroll
                    for (int q = 0; q < 4; ++q) { const float r0 = __builtin_amdgcn_fractf(posf[ai][m] * fsc[q]), r1 = __builtin_amdgcn_fractf(posf[ai][m] * fsc[4 + q]);
                        c0[q] = __builtin_amdgcn_cosf(r0); s0[q] = __builtin_amdgcn_sinf(r0); c1[q] = __builtin_amdgcn_cosf(r1); s1[q] = __builtin_amdgcn_sinf(r1); }
                    const float rsc = sr[ai][m];
                    const f32x4 x1a = tof(acc[ai][0][m][0]) * rsc * sv[0][0], x1b = tof(acc[ai][0][m][1]) * rsc * sv[0][1], x2a = tof(acc[ai][1][m][0]) * rsc * sv[1][0], x2b = tof(acc[ai][1][m][1]) * rsc * sv[1][1];
                    const f32x4 o1a = x1a * c0 - x2a * s0, o1b = x1b * c1 - x2b * s1, o2a = x2a * c0 + x1a * s0, o2b = x2b * c1 + x1b * s1;
                    bf16_t* rp = P + PLO(cbu) + (size_t)row * PP + (cbu & 2047);
                    u32x4 w; w.x = cvt_pk_bf16(o1a[0], o1a[1]); w.y = cvt_pk_bf16(o1a[2], o1a[3]); w.z = cvt_pk_bf16(o1b[0], o1b[1]); w.w = cvt_pk_bf16(o1b[2], o1b[3]);
                    stu<u32x4>(rp, vP, w);
                    w.x = cvt_pk_bf16(o2a[0], o2a[1]); w.y = cvt_pk_bf16(o2a[2], o2a[3]); w.z = cvt_pk_bf16(o2b[0], o2b[1]); w.w = cvt_pk_bf16(o2b[2], o2b[3]);
                    stu<u32x4>(rp + 64, vP, w); }
            return true;
        }
        const int act = (pn >= 80) ? 2 : 0;
        f32x4 bv[2][2];
#pragma unroll
        for (int bj = 0; bj < 2; ++bj)
#pragma unroll
            for (int n = 0; n < 2; ++n) bv[bj][n] = (act == 2) ? ldu<f32x4>(gate_b + (cbu - COL_GL) + bj * 64 + 4 * n, (unsigned)(8 * fq) * 4u) : (f32x4){0.f, 0.f, 0.f, 0.f};
        if (act == 2) {
#pragma unroll
            for (int bj = 0; bj < 2; ++bj)
#pragma unroll
                for (int n = 0; n < 2; ++n) { sv[bj][n] = sv[bj][n] * -1.4426950408889634f; bv[bj][n] = bv[bj][n] * -1.4426950408889634f; } }
#pragma unroll
        for (int ai = 0; ai < 2; ++ai)
#pragma unroll
            for (int m = 0; m < 4; ++m) { bf16_t* rp = P + PLO(cbu) + (size_t)(rowu + ai * HALF + m * 16) * PP + (cbu & 2047);
#pragma unroll
                for (int bj = 0; bj < 2; ++bj) { f32x4 v0, v1;
#pragma unroll
                    for (int q = 0; q < 4; ++q) { v0[q] = (float)acc[ai][bj][m][0][q] * sr[ai][m] * sv[bj][0][q] + bv[bj][0][q]; v1[q] = (float)acc[ai][bj][m][1][q] * sr[ai][m] * sv[bj][1][q] + bv[bj][1][q]; }
                    if (act == 1) {
#pragma unroll
                        for (int q = 0; q < 4; ++q) { v0[q] = fast_silu(v0[q]); v1[q] = fast_silu(v1[q]); } }
                    else if (act == 2) {
#pragma unroll
                        for (int q = 0; q < 4; ++q) { v0[q] = __builtin_amdgcn_rcpf(1.0f + __builtin_amdgcn_exp2f(v0[q])); v1[q] = __builtin_amdgcn_rcpf(1.0f + __builtin_amdgcn_exp2f(v1[q])); } }
                    u32x4 w; w.x = cvt_pk_bf16(v0[0], v0[1]); w.y = cvt_pk_bf16(v0[2], v0[3]); w.z = cvt_pk_bf16(v1[0], v1[1]); w.w = cvt_pk_bf16(v1[2], v1[3]);
                    stu<u32x4>(rp + bj * 64, vP, w); } }
        return true;
    }
};
struct EpiMerge {
    static constexpr int BPERM = 1;
    bf16_t* MG; const bf16_t* P;
    __device__ __forceinline__ bool operator()(f32x4 (&acc)[2][2][4][2], const Unit& u, int wr, int wc, int fr, int fq) const {
        const int rowu = u.pm * BM + wr * 64, colu = u.pn * BM + wc * 32, j = u.j;
        const unsigned vP = (unsigned)(fr * PP + 8 * fq) * 2u, vM = (unsigned)(fr * DM + 8 * fq) * 2u;
#pragma unroll
        for (int ai = 0; ai < 2; ++ai) {
            u32x4 gw[4][2], nw[4][2];
#pragma unroll
            for (int m = 0; m < 4; ++m) { const bf16_t* gp = P + PLO(COL_GL + j * DM + colu) + (size_t)(rowu + ai * HALF + m * 16) * PP + (colu & 2047);
#pragma unroll
                for (int bj = 0; bj < 2; ++bj) { gw[m][bj] = ldu<u32x4>(gp + bj * HALF, vP); if (j < 2) nw[m][bj] = ldu<u32x4>(gp + 2 * PLANE + bj * HALF, vP); } }
#pragma unroll
            for (int m = 0; m < 4; ++m) { const int row = rowu + ai * HALF + m * 16;
#pragma unroll
                for (int bj = 0; bj < 2; ++bj) {
                    float gj[8]; unpack8(gw[m][bj], gj);
                    if (j < 2) { float gn[8]; unpack8(nw[m][bj], gn);
#pragma unroll
                        for (int q = 0; q < 8; ++q) gj[q] = gj[q] * __builtin_amdgcn_rcpf(fmaxf(gn[q], 1e-30f)); }
#pragma unroll
                    for (int q = 0; q < 4; ++q) { acc[ai][bj][m][0][q] *= gj[q]; acc[ai][bj][m][1][q] *= gj[4 + q]; }
                    if (j == 2) { const f32x4 v0 = acc[ai][bj][m][0], v1 = acc[ai][bj][m][1];
                        u32x4 w; w.x = cvt_pk_bf16(v0[0], v0[1]); w.y = cvt_pk_bf16(v0[2], v0[3]); w.z = cvt_pk_bf16(v1[0], v1[1]); w.w = cvt_pk_bf16(v1[2], v1[3]);
                        stu<u32x4>(MG + (size_t)row * DM + colu + bj * HALF, vM, w); } } }
            asm volatile("" ::: "memory"); }
        return j == 2;
    }
};
template <bool F32IN> struct EpiOut {
    static constexpr int BPERM = 1;
    const void* XI; bf16_t* XO;
    __device__ __forceinline__ bool operator()(f32x4 (&acc)[2][2][4][2], const Unit& u, int wr, int wc, int fr, int fq) const {
        const int rowu = u.pm * BM + wr * 64, colu = u.pn * BM + wc * 32;
        const unsigned vI = (unsigned)(fr * DM + 8 * fq) * (F32IN ? 4u : 2u), vO = (unsigned)(fr * DM + 8 * fq) * 2u;
#pragma unroll
        for (int ai = 0; ai < 2; ++ai) {
            f32x4 xa[4][2], xb[4][2]; u32x4 xh[4][2];
#pragma unroll
            for (int m = 0; m < 4; ++m)
#pragma unroll
                for (int bj = 0; bj < 2; ++bj) { const size_t o = (size_t)(rowu + ai * HALF + m * 16) * DM + colu + bj * HALF;
                    if constexpr (F32IN) { xa[m][bj] = ldu<f32x4>((const float*)XI + o, vI); xb[m][bj] = ldu<f32x4>((const float*)XI + o + 4, vI); }
                    else xh[m][bj] = ldu<u32x4>((const bf16_t*)XI + o, vI); }
#pragma unroll
            for (int m = 0; m < 4; ++m)
#pragma unroll
                for (int bj = 0; bj < 2; ++bj) { const size_t o = (size_t)(rowu + ai * HALF + m * 16) * DM + colu + bj * HALF;
                    f32x4 r0, r1;
                    if constexpr (F32IN) { r0 = xa[m][bj]; r1 = xb[m][bj]; }
                    else { const u32x4 h = xh[m][bj]; r0 = (f32x4){bf_lo(h.x), bf_hi(h.x), bf_lo(h.y), bf_hi(h.y)}; r1 = (f32x4){bf_lo(h.z), bf_hi(h.z), bf_lo(h.w), bf_hi(h.w)}; }
                    r0 = r0 + acc[ai][bj][m][0]; r1 = r1 + acc[ai][bj][m][1];
                    u32x4 w; w.x = cvt_pk_bf16(r0[0], r0[1]); w.y = cvt_pk_bf16(r0[2], r0[3]); w.z = cvt_pk_bf16(r1[0], r1[1]); w.w = cvt_pk_bf16(r1[2], r1[3]);
                    stu<u32x4>(XO + o, vO, w); }
            asm volatile("" ::: "memory"); }
        return true;
    }
};
}

namespace att {
constexpr float SCALE = 0.08838834764831845f;
constexpr int NW = 8, QBLK = 32, KVBLK = 64, QB = NW * QBLK, D = 128;
constexpr int SHM_V = KVBLK * D * 2, SHM_K = KVBLK * D * 2;
constexpr float THR = 8.f;
constexpr int PQ = PP, PKV = PP, PO = DM;
constexpr int WIN = SEQ;
#define KSWZ(row, colB) ((row) * 256 + ((colB) ^ (((row) & 7) << 4)))
#define SBAR() __builtin_amdgcn_sched_barrier(0)
__device__ __forceinline__ int v_st(int k, int c) { const int kk = (k & ~0xC) | ((k & 4) << 1) | ((k & 8) >> 1); return ((kk >> 3) * 4 + (c >> 5)) * 512 + ((kk & 7) * 32 + (c & 31)) * 2; }
__device__ __forceinline__ int v_rd_base(int lane) { return ((lane & 3) << 3) | (((lane >> 2) & 3) << 6) | (((lane >> 4) & 1) << 5) | (((lane >> 5) & 1) << 8); }
constexpr int v_rd_off(int d0, int ks, int half) { return d0 * 512 + ks * 4096 + half * 2048; }
__device__ __forceinline__ int crow(int r, int hi) { return (r & 3) + 8 * (r >> 2) + 4 * hi; }
__device__ __forceinline__ unsigned cvtpk(float lo, float hi) { unsigned r; asm volatile("v_cvt_pk_bf16_f32 %0, %1, %2" : "=v"(r) : "v"(lo), "v"(hi)); return r; }
__device__ __forceinline__ bf16x8 load8(const bf16_t* p) { return *reinterpret_cast<const bf16x8*>(p); }
__device__ __forceinline__ void mask_tile(f32x16& p0, f32x16& p1, int dq, unsigned W) {
    const float NEG = -__builtin_inff();
#pragma unroll
    for (int r = 0; r < 16; ++r) {
        const int c = (r & 3) + 8 * (r >> 2);
        if ((unsigned)(dq - c) >= W) p0[r] = NEG;
        if ((unsigned)(dq - c - 32) >= W) p1[r] = NEG;
    }
}
__device__ __forceinline__ void partialSM(f32x16& p0, f32x16& p1, float& m_reg, float& mn, float& alpha) {
    float pmax = p0[0]; for (int r = 1; r < 16; ++r) pmax = fmaxf(pmax, p0[r]); for (int r = 0; r < 16; ++r) pmax = fmaxf(pmax, p1[r]);
    { auto rr = __builtin_amdgcn_permlane32_swap(__float_as_uint(pmax), __float_as_uint(pmax), false, false);
      pmax = fmaxf(__uint_as_float(rr[0]), __uint_as_float(rr[1])); }
    constexpr float C2 = 1.4426950408889634f * SCALE;
    if (__builtin_expect(__all((pmax - m_reg) * SCALE <= THR), 1)) { mn = m_reg; alpha = 1.f; }
    else { mn = fmaxf(m_reg, pmax); alpha = __builtin_amdgcn_exp2f((m_reg - mn) * C2); m_reg = mn; }
    const float mnL = -mn * C2;
    for (int r = 0; r < 16; ++r) p0[r] = fmaf(p0[r], C2, mnL); for (int r = 0; r < 16; ++r) p1[r] = fmaf(p1[r], C2, mnL);
    for (int r = 0; r < 16; ++r) p0[r] = __builtin_amdgcn_exp2f(p0[r]);
}
__device__ __forceinline__ void finishSM(f32x16& p0, f32x16& p1, float alpha, float& l_reg, bf16x8& pa0, bf16x8& pa1, bf16x8& pa2, bf16x8& pa3) {
    for (int r = 0; r < 16; ++r) p1[r] = __builtin_amdgcn_exp2f(p1[r]);
    float ps = 0; for (int r = 0; r < 16; ++r) ps += p0[r]; for (int r = 0; r < 16; ++r) ps += p1[r];
    { auto rr = __builtin_amdgcn_permlane32_swap(__float_as_uint(ps), __float_as_uint(ps), false, false);
      ps = __uint_as_float(rr[0]) + __uint_as_float(rr[1]); }
    l_reg = l_reg * alpha + ps;
#define PK4(P, B_, OUT) do { unsigned a0 = cvtpk(P[B_+0], P[B_+1]), a1 = cvtpk(P[B_+2], P[B_+3]);                          \
        unsigned b0 = cvtpk(P[B_+4], P[B_+5]), b1 = cvtpk(P[B_+6], P[B_+7]);                                             \
        auto r0 = __builtin_amdgcn_permlane32_swap(a0, b0, false, false); auto r1 = __builtin_amdgcn_permlane32_swap(a1, b1, false, false); \
        u32x4 w = {r0[0], r1[0], r0[1], r1[1]}; OUT = *reinterpret_cast<bf16x8*>(&w); } while (0)
    PK4(p0, 0, pa0); PK4(p0, 8, pa1); PK4(p1, 0, pa2); PK4(p1, 8, pa3);
#undef PK4
}
__device__ __forceinline__ bf16x8 ldg8(const bf16_t* ubase, unsigned boff) { return *reinterpret_cast<const bf16x8*>((const char*)ubase + boff); }
constexpr int LDS2_V = 0, LDS2_K = 4 * SHM_V, LDS2_WS = 4 * SHM_V + 2 * SHM_K, LDS2_BYTES = LDS2_WS + NW * 64 * 4;
template <int VBASE>
__device__ __forceinline__ void pv_both(f32x16* o, int vb0, bf16x8 pa0, bf16x8 pa1, bf16x8 pa2, bf16x8 pa3) {
#define TRRD(dst, off) asm volatile("ds_read_b64_tr_b16 %0, %1 offset:%2" : "=&v"(dst) : "v"(vb0), "i"(off) : "memory")
#define RD8(S, g) do { constexpr int b_ = VBASE + ((g) >> 2) * SHM_V + ((g) & 3) * 512; \
        TRRD(S##l0, b_); TRRD(S##h0, b_ + 2048); TRRD(S##l1, b_ + 4096); TRRD(S##h1, b_ + 6144); TRRD(S##l2, b_ + 8192); TRRD(S##h2, b_ + 10240); TRRD(S##l3, b_ + 12288); TRRD(S##h3, b_ + 14336); } while (0)
#define MM4(S, g) do { \
        o[g] = __builtin_amdgcn_mfma_f32_32x32x16_bf16(pa0, (bf16x8){S##l0[0], S##l0[1], S##l0[2], S##l0[3], S##h0[0], S##h0[1], S##h0[2], S##h0[3]}, o[g], 0, 0, 0);   \
        o[g] = __builtin_amdgcn_mfma_f32_32x32x16_bf16(pa1, (bf16x8){S##l1[0], S##l1[1], S##l1[2], S##l1[3], S##h1[0], S##h1[1], S##h1[2], S##h1[3]}, o[g], 0, 0, 0);   \
        o[g] = __builtin_amdgcn_mfma_f32_32x32x16_bf16(pa2, (bf16x8){S##l2[0], S##l2[1], S##l2[2], S##l2[3], S##h2[0], S##h2[1], S##h2[2], S##h2[3]}, o[g], 0, 0, 0);   \
        o[g] = __builtin_amdgcn_mfma_f32_32x32x16_bf16(pa3, (bf16x8){S##l3[0], S##l3[1], S##l3[2], S##l3[3], S##h3[0], S##h3[1], S##h3[2], S##h3[3]}, o[g], 0, 0, 0); } while (0)
#define STEP_G(CUR, NXT, g) do { RD8(NXT, (g) + 1); asm volatile("s_waitcnt lgkmcnt(8)" ::: "memory"); SBAR(); MM4(CUR, g); } while (0)
    s16x4 Al0, Al1, Al2, Al3, Ah0, Ah1, Ah2, Ah3, Bl0, Bl1, Bl2, Bl3, Bh0, Bh1, Bh2, Bh3;
    RD8(A, 0);
    STEP_G(A, B, 0); STEP_G(B, A, 1); STEP_G(A, B, 2); STEP_G(B, A, 3); STEP_G(A, B, 4); STEP_G(B, A, 5); STEP_G(A, B, 6);
    asm volatile("s_waitcnt lgkmcnt(0)" ::: "memory"); SBAR(); MM4(B, 7);
#undef STEP_G
#undef MM4
#undef RD8
#undef TRRD
}
template <int KB>
__device__ __forceinline__ void qkt2(f32x16& p0, f32x16& p1, int ka0, int ka1, int ka2, int ka3, const bf16x8* qr) {
#define KRD(dst, a, off) asm volatile("ds_read_b128 %0, %1 offset:%2" : "=&v"(dst) : "v"(a), "i"(off) : "memory")
#define RDK(S, a, off) do { KRD(S##0, a, KB * SHM_K + (off)); KRD(S##1, a, KB * SHM_K + (off) + 8192); } while (0)
#define WK(n) do { asm volatile("s_waitcnt lgkmcnt(" #n ")" ::: "memory"); SBAR(); } while (0)
#define MMK(S, d) do { p0 = __builtin_amdgcn_mfma_f32_32x32x16_bf16(S##0, qr[d], p0, 0, 0, 0); p1 = __builtin_amdgcn_mfma_f32_32x32x16_bf16(S##1, qr[d], p1, 0, 0, 0); } while (0)
    bf16x8 A0, A1, B0, B1;
    p0 = f32x16{}; p1 = f32x16{};
    RDK(A, ka0, 0); RDK(B, ka1, 0);
    WK(2); MMK(A, 0); RDK(A, ka2, 0);
    WK(2); MMK(B, 1); RDK(B, ka3, 0);
    WK(2); MMK(A, 2); RDK(A, ka0, 128);
    WK(2); MMK(B, 3); RDK(B, ka1, 128);
    WK(2); MMK(A, 4); RDK(A, ka2, 128);
    WK(2); MMK(B, 5); RDK(B, ka3, 128);
    WK(2); MMK(A, 6);
    WK(0); MMK(B, 7);
#undef MMK
#undef WK
#undef RDK
#undef KRD
}
struct BlockRef2 { const bf16_t* Q; const bf16_t* K; const bf16_t* V; bf16_t* O; int P0; };
__device__ __forceinline__ void causal_block2(const BlockRef2& cur, char* lds) {
    const int wid = __builtin_amdgcn_readfirstlane(threadIdx.x >> 6), lane = fresh_lane(), r32 = lane & 31, hi = lane >> 5;
    constexpr int W = WIN;
    const int NT = cur.P0 / KVBLK + 4;
    const int qlo = cur.P0 + wid * QBLK, qm = qlo + r32 - 4 * hi;
    char* V_lds = lds + LDS2_V; char* K_lds = lds + LDS2_K;
    float* ws = (float*)(lds + LDS2_WS) + wid * 64; float* li_l = ws, * al_l = ws + 32;
    const int vb0 = (int)(uintptr_t)V_lds + v_rd_base(lane);
    const int kab = (int)(uintptr_t)K_lds, ka0 = kab + KSWZ(r32, (0 * 16 + hi * 8) * 2), ka1 = kab + KSWZ(r32, (1 * 16 + hi * 8) * 2), ka2 = kab + KSWZ(r32, (2 * 16 + hi * 8) * 2), ka3 = kab + KSWZ(r32, (3 * 16 + hi * 8) * 2);
    unsigned ksrc[2], vsrc[2];
#pragma unroll
    for (int i = 0; i < 2; ++i) { const int o = i * 8192 + wid * 1024 + lane * 16;
        { const int row = o >> 8, p = (o >> 4) & 15, c = p ^ (row & 7); ksrc[i] = (unsigned)(row * PKV + c * 8) * 2u; }
        { const int q = o >> 4, sub = q >> 5, w4 = q & 31, kk = (sub >> 2) * 8 + (w4 >> 2), c = (sub & 3) * 32 + (w4 & 3) * 8, key = (kk & ~0xC) | ((kk & 4) << 1) | ((kk & 8) >> 1);
          vsrc[i] = (unsigned)(key * PKV + c) * 2u; } }
    const unsigned ldsw = (unsigned)wid * 1024u;
#define DMA16(gp, ldsoff) __builtin_amdgcn_global_load_lds((const unsigned*)(gp), (LAS unsigned*)((LAS char*)lds + (ldsoff)), 16, 0, 0)
#define LOAD_KV(k0, bf) do { const char* kk_ = (const char*)(cur.K + (size_t)(k0) * PKV); const char* vk_ = (const char*)(cur.V + (size_t)(k0) * PKV);            \
        _Pragma("unroll") for (int i_ = 0; i_ < 2; ++i_) { DMA16(kk_ + ksrc[i_], LDS2_K + (bf) * SHM_K + ldsw + i_ * 8192);                                          \
            DMA16(vk_ + vsrc[i_], LDS2_V + ((bf) * 2 + 0) * SHM_V + ldsw + i_ * 8192); DMA16(vk_ + 256 + vsrc[i_], LDS2_V + ((bf) * 2 + 1) * SHM_V + ldsw + i_ * 8192); } } while (0)
    bf16x8 qr[8];
    { const bf16_t* qb = cur.Q + (size_t)(wid * QBLK) * PQ; const unsigned qoff = (unsigned)(r32 * PQ + hi * 8) * 2u;
#pragma unroll
      for (int d0 = 0; d0 < 8; ++d0) qr[d0] = ldg8(qb, qoff + d0 * 32); }
    LOAD_KV(0, 0);
    asm volatile("s_waitcnt vmcnt(0)" ::: "memory"); __builtin_amdgcn_s_barrier(); asm volatile("" ::: "memory");
    float m_reg = -1e30f, l_reg = 0; f32x16 o[8] = {};
#define STEP2(t, CB) do { f32x16 p0, p1; float mn, al; bf16x8 pa0, pa1, pa2, pa3;                                                               \
        if ((t) + 1 < NT) { LOAD_KV(((t) + 1) * KVBLK, (CB) ^ 1); } SBAR();                                                                    \
        qkt2<CB>(p0, p1, ka0, ka1, ka2, ka3, qr);                                                                                                   \
        { const int kb_ = (t) * KVBLK; if (kb_ + KVBLK - 1 > qlo) mask_tile(p0, p1, qm - kb_, (unsigned)W); }                                     \
        partialSM(p0, p1, m_reg, mn, al);                                                                                                       \
        if (__any(al < 1.f)) { if (hi == 0) al_l[r32] = al; asm volatile("s_waitcnt lgkmcnt(0)" ::: "memory");                                    \
            for (int d_ = 0; d_ < 8; ++d_) for (int r = 0; r < 16; ++r) o[d_][r] *= al_l[crow(r, hi)]; }                                          \
        finishSM(p0, p1, al, l_reg, pa0, pa1, pa2, pa3); SBAR();                                                                                \
        pv_both<(CB) * 2 * SHM_V>(o, vb0, pa0, pa1, pa2, pa3);             \
        asm volatile("s_waitcnt vmcnt(0) lgkmcnt(0)" ::: "memory"); __builtin_amdgcn_s_barrier(); asm volatile("" ::: "memory"); } while (0)
    for (int t = 0; t < NT; t += 2) { STEP2(t, 0); STEP2(t + 1, 1); }
#undef STEP2
#undef LOAD_KV
#undef DMA16
    const int lz = fresh_lane(), r32z = lz & 31, hiz = lz >> 5;
    if (hiz == 0) li_l[r32z] = l_reg; asm volatile("s_waitcnt lgkmcnt(0)" ::: "memory");
    float rli[16];
#pragma unroll
    for (int r = 0; r < 16; ++r) rli[r] = __builtin_amdgcn_rcpf(li_l[crow(r, hiz)]);
    unsigned zhi = 0u; asm volatile("" : "+v"(zhi));
    char* lanep = (char*)(cur.O + (size_t)(wid * QBLK) * PO) + (((size_t)zhi << 32) | (size_t)((unsigned)(hiz * 4 * PO + r32z) * 2u));
#pragma unroll
    for (int r = 0; r < 16; ++r) { const int rb = (r & 3) + 8 * (r >> 2);
#pragma unroll
        for (int d0 = 0; d0 < 8; ++d0) { const float v = o[d0][r] * rli[r];
            const float vn = __shfl_xor(v, 1);
            if ((r32z & 1) == 0) *(unsigned*)(lanep + (size_t)rb * PO * 2 + d0 * 64) = cvtpk(v, vn); } }
    asm volatile("s_waitcnt lgkmcnt(0)" ::: "memory"); __builtin_amdgcn_s_barrier(); asm volatile("" ::: "memory");
}
}

constexpr size_t MiB = (size_t)1 << 20;
constexpr size_t WS_CTL = 0, CTL_ZERO_BYTES = 1 * MiB;
constexpr size_t WS_C8 = 9 * MiB;
constexpr size_t WS_CARA = 10 * MiB, WS_CARH = 12 * MiB, WS_CIN = 14 * MiB;
constexpr size_t WS_WG = 16 * MiB;
constexpr size_t WS_WO = 32 * MiB;
constexpr size_t WS_WB = 160 * MiB;
constexpr size_t WS_WIN = 352 * MiB;
constexpr size_t WS_H = 1376 * MiB;
constexpr size_t WS_PROJ = 1504 * MiB;
constexpr size_t WS_HL = 2720 * MiB;
constexpr size_t WS_OB = 2848 * MiB;
constexpr size_t WS_Y = 2976 * MiB;
constexpr size_t WS_MG = 3168 * MiB;
constexpr size_t WS_XB = 3296 * MiB;
constexpr size_t WS_XB1 = 3552 * MiB;
constexpr size_t WS_WQ = 3808 * MiB;
constexpr size_t WS_HQ = 4320 * MiB;
constexpr size_t WS_END = 4384 * MiB;
constexpr size_t WS_SW = 9 * MiB + 64 * 1024;
constexpr size_t WS_SA = 9 * MiB + 640 * 1024;
constexpr int CW_BAR = 4096;
constexpr int CW_DBG = 65536;

constexpr int RING_OFF = 0, RING_BYTES = 131072;
constexpr int LDS_BYTES = 147456;
constexpr int LDSCTL_OFF = LDS_BYTES - 1024, MISC_OFF = LDSCTL_OFF + 320;
constexpr int NWAVES = 8;

#define XB_TMO      128
#define XB_XCNT(j)  (256  + 64 * (j))
#define XB_XSUB(j)  (1280 + 64 * (j))
#define XB_XGEN(j)  (2304 + 64 * (j))
#define XB_TOP      3328
#define XB_TOPGEN   3392
#define XCD_BAR_WORDS 3456
#define XB_SPIN_CAP (1u << 18)
__device__ __forceinline__ unsigned xb_ld(unsigned* p)              { return __hip_atomic_load(p, __ATOMIC_RELAXED, __HIP_MEMORY_SCOPE_AGENT); }
__device__ __forceinline__ unsigned xb_add(unsigned* p, unsigned v) { return __hip_atomic_fetch_add(p, v, __ATOMIC_RELAXED, __HIP_MEMORY_SCOPE_AGENT); }
__device__ __forceinline__ unsigned xb_xcc_id() { return (unsigned)__builtin_amdgcn_s_getreg((3 << 11) | 20) & 0xFu; }
#define XB_SPIN(cond, bar) do { unsigned _sp = 0; while (cond) { __builtin_amdgcn_s_sleep(1); \
    if ((++_sp & 255u) == 0u) { if (xb_ld(&(bar)[XB_TMO])) break; if (_sp > XB_SPIN_CAP) { atomicAdd(&(bar)[XB_TMO], 1u); break; } } } } while (0)
struct XcdBarrier { unsigned* bar; unsigned x; volatile LAS unsigned* st; };
__device__ __forceinline__ XcdBarrier xcd_barrier_post(unsigned* bar, volatile LAS unsigned* st) {
    XcdBarrier b; b.bar = bar; b.x = xb_xcc_id(); b.st = st;
    if (threadIdx.x == 0) (void)xb_add(&bar[XB_XCNT(b.x)], 1u);
    return b;
}
__device__ __forceinline__ void xcd_barrier_complete(unsigned* bar, unsigned x, unsigned& nloc, unsigned& nx) {
    const unsigned G = gridDim.x * gridDim.y * gridDim.z;
    unsigned sum, cnt, mine, sp = 0u;
    for (;;) {
        sum = 0u; cnt = 0u; mine = 0u;
#pragma unroll
        for (unsigned j = 0; j < 16; ++j) { const unsigned c = xb_ld(&bar[XB_XCNT(j)]); sum += c; cnt += (c > 0u) ? 1u : 0u; mine = (j == x) ? c : mine; }
        if (sum == G) break;
        __builtin_amdgcn_s_sleep(1);
        if ((++sp & 255u) == 0u) { if (xb_ld(&bar[XB_TMO])) break; if (sp > XB_SPIN_CAP) { atomicAdd(&bar[XB_TMO], 1u); break; } }
    }
    nloc = mine > 0u ? mine : 1u; nx = cnt > 0u ? cnt : 1u;
}
__device__ __forceinline__ void xcd_barrier(const XcdBarrier& b) {
    asm volatile("s_waitcnt vmcnt(0)" ::: "memory");
    __syncthreads();
    if (threadIdx.x == 0) {
        unsigned* bar = b.bar;
        __builtin_amdgcn_s_waitcnt(0);
        unsigned nloc = b.st[0], nx = b.st[1];
        if (nloc == 0u) { xcd_barrier_complete(bar, b.x, nloc, nx); b.st[0] = nloc; b.st[1] = nx; }
        const unsigned old = xb_add(&bar[XB_XSUB(b.x)], 1u);
        const unsigned gen = old / nloc;
        if (old + 1u == (gen + 1u) * nloc) {
            __builtin_amdgcn_fence(__ATOMIC_RELEASE, "agent");
            asm volatile("s_waitcnt vmcnt(0)" ::: "memory");
            const unsigned og = xb_add(&bar[XB_TOP], 1u);
            const unsigned tg = og / nx;
            if (og + 1u == (tg + 1u) * nx) xb_add(&bar[XB_TOPGEN], 1u);
            else XB_SPIN(xb_ld(&bar[XB_TOPGEN]) == tg, bar);
            __builtin_amdgcn_fence(__ATOMIC_ACQUIRE, "agent");
            xb_add(&bar[XB_XGEN(b.x)], 1u);
            asm volatile("s_waitcnt vmcnt(0)" ::: "memory");
        } else {
            XB_SPIN(xb_ld(&bar[XB_XGEN(b.x)]) == gen, bar);
            __builtin_amdgcn_fence(__ATOMIC_ACQUIRE, "agent");
            asm volatile("s_waitcnt vmcnt(0)" ::: "memory");
        }
    }
    __syncthreads();
}

#define LDS_WAIT() asm volatile("s_waitcnt lgkmcnt(0)" ::: "memory")
struct Frame {
    LAS unsigned char* lds;
    int wave, vcu, G;
    int gw, NGW, NGT;
    unsigned char* ws;
    const void* const* in;
    float* out;
    __device__ __forceinline__ const float* fin(int k) const { int kk = k; asm volatile("" : "+s"(kk)); return (const float*)in[kk]; }
    __device__ __forceinline__ int gwo() const { int g = gw; asm volatile("" : "+s"(g)); return g; }
    __device__ __forceinline__ unsigned char* wsp(size_t off) const { size_t z = 0; asm volatile("" : "+s"(z)); return ws + (z + off); }
};
enum { I_X = 0, I_POS, I_NORM_W, I_W_IN, I_GATE_B, I_CONV_A_W, I_CONV_A_B, I_W_RG, I_B_RG, I_W_IG, I_B_IG, I_LAMBDA, I_LQ1, I_LK1, I_LQ2, I_LK2, I_SUBLN, I_CONV_C_W, I_W_BRANCH, I_W_OUT, I_FINAL_W };

__device__ __forceinline__ void transpose_item(const float* src, int N, int k0, int n0, bf16_t* dst, int dpitch, LAS float* scr, int lane) {
#pragma unroll 8
    for (int i = 0; i < 32; ++i) { const int kk = 2 * i + (lane >> 5); scr[kk * 33 + (lane & 31)] = src[(size_t)(k0 + kk) * N + n0 + (lane & 31)]; }
    LDS_WAIT(); asm volatile("" ::: "memory");
    const int c = lane & 7;
#pragma unroll
    for (int j = 0; j < 4; ++j) { const int n = (lane >> 3) + 8 * j; const LAS float* s = scr + (8 * c) * 33 + n;
        u32x4 o; o.x = cvt_pk_bf16(s[0 * 33], s[1 * 33]); o.y = cvt_pk_bf16(s[2 * 33], s[3 * 33]); o.z = cvt_pk_bf16(s[4 * 33], s[5 * 33]); o.w = cvt_pk_bf16(s[6 * 33], s[7 * 33]);
        *(u32x4*)(dst + (size_t)n * dpitch + 8 * c) = o; }
    LDS_WAIT(); asm volatile("" ::: "memory");
}
__device__ __forceinline__ void p_prologue(Frame& F) {
    const int lane = fresh_lane(), tid = F.wave * 64 + lane, gt = F.gw * 64 + lane; (void)gt; (void)tid;
    LAS float* scr = (LAS float*)(F.lds + RING_OFF + F.wave * 16384);
    constexpr int I_IN = (DM / 64) * (NB_TILES * 8);
    constexpr int I_BR = (BW / 64) * (DM / 32);
    constexpr int I_OUT = (DM / 64) * (DM / 32);
    constexpr int I_G = (256 / 64) * (256 / 32);
    constexpr int T_IN = DEPTH * I_IN, T_BR = DEPTH * 3 * I_BR, T_OUT = DEPTH * I_OUT, T_G = DEPTH * 8 * 2 * I_G;
    constexpr int NITEMS = T_IN + T_BR + T_OUT + T_G;
    bf16_t* WIN = (bf16_t*)F.wsp(WS_WIN); bf16_t* WB = (bf16_t*)F.wsp(WS_WB); bf16_t* WO = (bf16_t*)F.wsp(WS_WO); bf16_t* WG = (bf16_t*)F.wsp(WS_WG);
    for (int it = F.gw; it < NITEMS; it += F.NGW) {
        int r = it;
        if (r < T_IN) { const int l = r / I_IN; r -= l * I_IN; const int nblk = NB_TILES * 8, kb = r / nblk, nb = r % nblk, n0 = b_tile(nb >> 3) * 256 + (nb & 7) * 32;
            transpose_item(F.fin(I_W_IN) + (size_t)l * DM * INC, INC, 64 * kb, n0, WIN + (size_t)l * INC * DM + (size_t)n0 * DM + 64 * kb, DM, scr, lane); continue; }
        r -= T_IN;
        if (r < T_BR) { const int lj = r / I_BR; r -= lj * I_BR; const int l = lj / 3, j = lj - 3 * l; const int nblk = DM / 32, kb = r / nblk, nb = r % nblk;
            transpose_item(F.fin(I_W_BRANCH) + (size_t)lj * BW * DM, DM, 64 * kb, 32 * nb, WB + (size_t)l * DM * YW + (size_t)(32 * nb) * YW + j * BW + 64 * kb, YW, scr, lane); continue; }
        r -= T_BR;
        if (r < T_OUT) { const int l = r / I_OUT; r -= l * I_OUT; const int nblk = DM / 32, kb = r / nblk, nb = r % nblk;
            transpose_item(F.fin(I_W_OUT) + (size_t)l * DM * DM, DM, 64 * kb, 32 * nb, WO + (size_t)l * DM * DM + (size_t)(32 * nb) * DM + 64 * kb, DM, scr, lane); continue; }
        r -= T_OUT;
        { const int lng = r / I_G; r -= lng * I_G; const int gate = lng & 1, ln = lng >> 1, n = ln & 7, l = ln >> 3; const int kb = r / 8, nb = r % 8, n0 = 32 * nb;
            const float* src = (gate ? F.fin(I_W_IG) : F.fin(I_W_RG)) + (size_t)(l * 8 + n) * 65536;
            bf16_t* dst = WG + (size_t)l * 16 * 65536 + (size_t)((n * 2 + (n0 >> 7)) * 256 + gate * 128 + (n0 & 127)) * 256 + 64 * kb;
            transpose_item(src, 256, 64 * kb, n0, dst, 256, scr, lane); }
    }
    float* C8 = (float*)F.wsp(WS_C8); const float* lamp = F.fin(I_LAMBDA);
    for (int idx = gt; idx < DEPTH * BW; idx += F.NGT) { const float lam = lamp[idx]; const float ls = -log1pf(expf(-lam)); C8[idx] = 8.0f * 1.4426950408889634f * ls; }
}

__device__ __forceinline__ float wave_max(float v) {
#pragma unroll
    for (int o = 1; o < 64; o <<= 1) v = fmaxf(v, __shfl_xor(v, o));
    return v;
}
__device__ __forceinline__ unsigned pack_i8x4(float a, float b, float c, float d) {
    const int ia = (int)__builtin_rintf(a), ib = (int)__builtin_rintf(b), ic = (int)__builtin_rintf(c), id = (int)__builtin_rintf(d);
    return ((unsigned)ia & 0xffu) | (((unsigned)ib & 0xffu) << 8) | (((unsigned)ic & 0xffu) << 16) | ((unsigned)id << 24);
}
template <bool F32IN> __device__ __forceinline__ void p_rmsnorm_bf16(Frame& F, const void* X, const float* w, bf16_t* H) {
    const int lane = fresh_lane();
    signed char* HQ = (signed char*)F.wsp(WS_HQ); float* SA = (float*)F.wsp(WS_SA);
    f32x4 wreg[16];
#pragma unroll
    for (int j = 0; j < 16; ++j) wreg[j] = ((const f32x4*)w)[lane + 64 * j];
    for (int row = F.gwo(); row < MTOK; row += F.NGW) {
        f32x4 v[16]; float s = 0.f, mx = 0.f;
        if constexpr (F32IN) { const f32x4* xr = (const f32x4*)((const float*)X + (size_t)row * DM) + lane;
#pragma unroll
            for (int j = 0; j < 16; ++j) v[j] = xr[64 * j]; }
        else { const u32x2* xr = (const u32x2*)((const bf16_t*)X + (size_t)row * DM) + lane;
#pragma unroll
            for (int j = 0; j < 16; ++j) { const u32x2 h = xr[64 * j]; v[j] = (f32x4){bf_lo(h.x), bf_hi(h.x), bf_lo(h.y), bf_hi(h.y)}; } }
#pragma unroll
        for (int j = 0; j < 16; ++j) s += (v[j].x * v[j].x + v[j].y * v[j].y) + (v[j].z * v[j].z + v[j].w * v[j].w);
#pragma unroll
        for (int j = 0; j < 16; ++j) { v[j] = v[j] * wreg[j];
            mx = fmaxf(fmaxf(mx, fmaxf(__builtin_fabsf(v[j].x), __builtin_fabsf(v[j].y))), fmaxf(__builtin_fabsf(v[j].z), __builtin_fabsf(v[j].w))); }
        const float rs = 1.0f / __builtin_sqrtf(wave_sum(s) * (1.0f / DM) + 1e-6f);
        const float amax = wave_max(mx) * rs;
        const float sc = amax > 0.f ? amax * (1.0f / 127.0f) : 1.0f, qi = rs / sc;
        u32x2* o8 = (u32x2*)(H + (size_t)row * DM) + lane;
        unsigned* q4 = (unsigned*)(HQ + (size_t)row * DM) + lane;
#pragma unroll
        for (int j = 0; j < 16; ++j) { u32x2 o; o.x = cvt_pk_bf16(v[j].x * rs, v[j].y * rs); o.y = cvt_pk_bf16(v[j].z * rs, v[j].w * rs); o8[64 * j] = o;
            q4[64 * j] = pack_i8x4(v[j].x * qi, v[j].y * qi, v[j].z * qi, v[j].w * qi); }
        if (lane == 0) SA[row] = sc;
    }
}
__device__ __forceinline__ void p_wquant(Frame& F) {
    const int lane = fresh_lane();
    const bf16_t* WIN = (const bf16_t*)F.wsp(WS_WIN); signed char* WQ = (signed char*)F.wsp(WS_WQ); float* SW = (float*)F.wsp(WS_SW);
    constexpr int NROW = NQ_TILES * 256;
    for (int i0 = F.gwo(); i0 < DEPTH * NROW; i0 += 2 * F.NGW) {
        u32x4 wv[2][8]; size_t rr[2]; bool ok[2];
#pragma unroll
        for (int k = 0; k < 2; ++k) { const int i = i0 + k * F.NGW; ok[k] = i < DEPTH * NROW; const int ii = ok[k] ? i : i0; const int l = ii / NROW, j0 = ii - l * NROW, n = q_tile(j0 >> 8) * 256 + (j0 & 255);
            rr[k] = (size_t)l * INC + n; const u32x4* src = (const u32x4*)(WIN + rr[k] * DM) + lane;
#pragma unroll
            for (int j = 0; j < 8; ++j) wv[k][j] = src[64 * j]; }
#pragma unroll
        for (int k = 0; k < 2; ++k) { float mx = 0.f;
#pragma unroll
            for (int j = 0; j < 8; ++j)
#pragma unroll
                for (int q = 0; q < 4; ++q) mx = fmaxf(mx, fmaxf(__builtin_fabsf(bf_lo(wv[k][j][q])), __builtin_fabsf(bf_hi(wv[k][j][q]))));
            const float amax = wave_max(mx), sc = amax > 0.f ? amax * (1.0f / 127.0f) : 1.0f, qi = 1.0f / sc;
            if (ok[k]) { u32x2* dst = (u32x2*)(WQ + rr[k] * DM) + lane;
#pragma unroll
                for (int j = 0; j < 8; ++j) { u32x2 o; o.x = pack_i8x4(bf_lo(wv[k][j].x) * qi, bf_hi(wv[k][j].x) * qi, bf_lo(wv[k][j].y) * qi, bf_hi(wv[k][j].y) * qi);
                    o.y = pack_i8x4(bf_lo(wv[k][j].z) * qi, bf_hi(wv[k][j].z) * qi, bf_lo(wv[k][j].w) * qi, bf_hi(wv[k][j].w) * qi); dst[64 * j] = o; }
                if (lane == 0) SW[rr[k]] = sc; } }
    }
}
constexpr int WQ_PITCH = 8208;
static_assert(16 * WQ_PITCH + 8 * 16 * 4 <= LDSCTL_OFF, "fused weight quantiser LDS map");
__device__ __forceinline__ void p_wquant_fused(Frame& F) {
    const int lane = fresh_lane(), wv = F.wave, tid = wv * 64 + lane, cp = lane & 7, rq = lane >> 3;
    LAS unsigned char* S = F.lds; LAS float* red = (LAS float*)(F.lds + 16 * WQ_PITCH);
    signed char* WQ = (signed char*)F.wsp(WS_WQ); float* SW = (float*)F.wsp(WS_SW);
    const float* win = F.fin(I_W_IN);
    constexpr int UPL = NQ_TILES * 16, NU = DEPTH * UPL;
    __syncthreads();
    for (int u = blockIdx.x; u < NU; u += F.G) {
        const int l = u / UPL, r0 = u - l * UPL, r = 2 * ((r0 >> 4) * 8 + (r0 & 7)) + ((r0 >> 3) & 1), n0 = q_tile(r >> 4) * 256 + (r & 15) * 16;
        const float* src = win + (size_t)l * DM * INC + n0 + 2 * cp;
        float mx0 = 0.f, mx1 = 0.f;
#pragma unroll 1
        for (int i0 = 0; i0 < 32; i0 += 8) {
            f32x2 a[8], b[8];
#pragma unroll
            for (int i = 0; i < 8; ++i) { const int k = (wv + 8 * (i0 + i)) * 16 + 2 * rq; a[i] = *(const f32x2*)(src + (size_t)k * INC); b[i] = *(const f32x2*)(src + (size_t)(k + 1) * INC); }
#pragma unroll
            for (int i = 0; i < 8; ++i) { const int k = (wv + 8 * (i0 + i)) * 16 + 2 * rq;
                const unsigned w0 = cvt_pk_bf16(a[i].x, b[i].x), w1 = cvt_pk_bf16(a[i].y, b[i].y);
                mx0 = fmaxf(mx0, fmaxf(__builtin_fabsf(bf_lo(w0)), __builtin_fabsf(bf_hi(w0)))); mx1 = fmaxf(mx1, fmaxf(__builtin_fabsf(bf_lo(w1)), __builtin_fabsf(bf_hi(w1))));
                *(LAS unsigned*)(S + (2 * cp) * WQ_PITCH + k * 2) = w0; *(LAS unsigned*)(S + (2 * cp + 1) * WQ_PITCH + k * 2) = w1; }
        }
#pragma unroll
        for (int o = 8; o < 64; o <<= 1) { mx0 = fmaxf(mx0, __shfl_xor(mx0, o)); mx1 = fmaxf(mx1, __shfl_xor(mx1, o)); }
        if (rq == 0) { red[wv * 16 + 2 * cp] = mx0; red[wv * 16 + 2 * cp + 1] = mx1; }
        __syncthreads();
        { const int n = tid >> 5, j = tid & 31;
          float amax = 0.f;
#pragma unroll
          for (int w = 0; w < 8; ++w) amax = fmaxf(amax, red[w * 16 + n]);
          const float sc = amax > 0.f ? amax * (1.0f / 127.0f) : 1.0f, qi = 1.0f / sc;
          const size_t row = (size_t)l * INC + n0 + n;
          const LAS unsigned char* sp = S + n * WQ_PITCH + j * 16;
          u32x2* dst = (u32x2*)(WQ + row * DM) + j;
#pragma unroll 4
          for (int m = 0; m < 16; ++m) { const u32x4 v = *(const LAS u32x4*)(sp + m * 512);
              u32x2 o; o.x = pack_i8x4(bf_lo(v.x) * qi, bf_hi(v.x) * qi, bf_lo(v.y) * qi, bf_hi(v.y) * qi); o.y = pack_i8x4(bf_lo(v.z) * qi, bf_hi(v.z) * qi, bf_lo(v.w) * qi, bf_hi(v.w) * qi);
              dst[32 * m] = o; }
          if (j == 0) SW[row] = sc; }
        __syncthreads();
    }
}
__device__ __forceinline__ void p_rmsnorm_f32(Frame& F, const bf16_t* X, const float* w, float* O) {
    const int lane = fresh_lane();
    f32x4 wreg[16];
#pragma unroll
    for (int j = 0; j < 16; ++j) wreg[j] = ((const f32x4*)w)[lane + 64 * j];
    for (int row = F.gwo(); row < MTOK; row += F.NGW) {
        const u32x2* xr = (const u32x2*)(X + (size_t)row * DM) + lane;
        f32x4 v[16]; float s = 0.f;
#pragma unroll
        for (int j = 0; j < 16; ++j) { const u32x2 h = xr[64 * j]; v[j] = (f32x4){bf_lo(h.x), bf_hi(h.x), bf_lo(h.y), bf_hi(h.y)}; s += (v[j].x * v[j].x + v[j].y * v[j].y) + (v[j].z * v[j].z + v[j].w * v[j].w); }
        const float rs = 1.0f / __builtin_sqrtf(wave_sum(s) * (1.0f / DM) + 1e-6f);
        f32x4* o = (f32x4*)(O + (size_t)row * DM) + lane;
#pragma unroll
        for (int j = 0; j < 16; ++j) o[64 * j] = v[j] * rs * wreg[j];
    }
}

constexpr int XT_PITCH = 544;
__device__ __forceinline__ void p_lru(Frame& F, int l) {
    const int lane = fresh_lane(), wv = F.wave, tid = wv * 64 + lane, fr = lane & 15, fq = lane >> 4;
    LAS unsigned char* XT = F.lds + RING_OFF;
    const bf16_t* P = (const bf16_t*)F.wsp(WS_PROJ);
    const bf16_t* WGl = (const bf16_t*)F.wsp(WS_WG) + (size_t)l * 16 * 65536;
    unsigned* HP = (unsigned*)F.wsp(WS_HL);
    float* CARA = (float*)F.wsp(WS_CARA); float* CARH = (float*)F.wsp(WS_CARH);
    const float* caw = F.fin(I_CONV_A_W) + (size_t)l * 4 * BW; const float* cab = F.fin(I_CONV_A_B) + (size_t)l * BW;
    const float* brg = F.fin(I_B_RG) + (size_t)l * BW; const float* big = F.fin(I_B_IG) + (size_t)l * BW; const float* c8 = (const float*)F.wsp(WS_C8) + (size_t)l * BW;
    constexpr int NUNIT = NBATCH * 8 * NCHUNK;
    const int n = blockIdx.x & 7;
    bf16x8 Br[2][8], Bi[2][8]; float vbr[2], vbi[2], vc8[2];
#pragma unroll
    for (int nt = 0; nt < 2; ++nt) { const int d = wv * 32 + nt * 16 + fr, ch = n * 256 + d;
        const bf16_t* wr_ = WGl + (size_t)((n * 2 + (d >> 7)) * 256 + (d & 127)) * 256 + 8 * fq;
#pragma unroll
        for (int ks = 0; ks < 8; ++ks) { Br[nt][ks] = *(const bf16x8*)(wr_ + ks * 32); Bi[nt][ks] = *(const bf16x8*)(wr_ + 128 * 256 + ks * 32); }
        vbr[nt] = brg[ch]; vbi[nt] = big[ch]; vc8[nt] = c8[ch]; }
    const int chg = n * 256 + (tid & 63) * 4;
    float cw[4][4], cbb[4];
#pragma unroll
    for (int j = 0; j < 4; ++j) { const f32x4 x0 = *(const f32x4*)(caw + (size_t)j * BW + chg);
#pragma unroll
        for (int q = 0; q < 4; ++q) cw[j][q] = x0[q]; }
    { const f32x4 x0 = *(const f32x4*)(cab + chg);
#pragma unroll
      for (int q = 0; q < 4; ++q) cbb[q] = x0[q]; }
    for (int rr = blockIdx.x >> 3; rr < NUNIT / 8; rr += F.G >> 3) {
        const int tile = rr & (NCHUNK - 1), b = rr / NCHUNK;
        const int s0 = tile * CHUNK; const size_t tok0 = (size_t)b * SEQ + s0;
        { const int rg = tid >> 6;
          const bf16_t* colp = P + PLO(COL_AX) + (tok0 + (size_t)rg * 16) * PP + chg;
          float xm3[4], xm2[4], xm1[4];
#pragma unroll
          for (int q = 0; q < 4; ++q) { xm3[q] = 0.f; xm2[q] = 0.f; xm1[q] = 0.f; }
          if (s0 + rg * 16 != 0) { const u32x2 h3 = *(const u32x2*)(colp - (size_t)3 * PP), h2 = *(const u32x2*)(colp - (size_t)2 * PP), h1 = *(const u32x2*)(colp - (size_t)1 * PP);
              xm3[0] = bf_lo(h3.x); xm3[1] = bf_hi(h3.x); xm3[2] = bf_lo(h3.y); xm3[3] = bf_hi(h3.y); xm2[0] = bf_lo(h2.x); xm2[1] = bf_hi(h2.x); xm2[2] = bf_lo(h2.y); xm2[3] = bf_hi(h2.y);
              xm1[0] = bf_lo(h1.x); xm1[1] = bf_hi(h1.x); xm1[2] = bf_lo(h1.y); xm1[3] = bf_hi(h1.y); }
#pragma unroll
          for (int hb = 0; hb < 2; ++hb) {
              u32x2 xr[8];
#pragma unroll
              for (int r = 0; r < 8; ++r) xr[r] = *(const u32x2*)(colp + (size_t)(hb * 8 + r) * PP);
#pragma unroll
              for (int r = 0; r < 8; ++r) { const float x0[4] = {bf_lo(xr[r].x), bf_hi(xr[r].x), bf_lo(xr[r].y), bf_hi(xr[r].y)}; float y[4];
#pragma unroll
                  for (int q = 0; q < 4; ++q) { y[q] = cbb[q] + cw[0][q] * xm3[q] + cw[1][q] * xm2[q] + cw[2][q] * xm1[q] + cw[3][q] * x0[q]; xm3[q] = xm2[q]; xm2[q] = xm1[q]; xm1[q] = x0[q]; }
                  u32x2 o; o.x = cvt_pk_bf16(y[0], y[1]); o.y = cvt_pk_bf16(y[2], y[3]);
                  *(LAS u32x2*)(XT + (rg * 16 + hb * 8 + r) * XT_PITCH + (tid & 63) * 8) = o; } }
        }
        __syncthreads();
        {
            float Ac[2] = {1.f, 1.f}, Hc[2] = {0.f, 0.f};
#pragma unroll 1
            for (int rt = 0; rt < CHUNK / 16; ++rt) {
                const LAS unsigned char* ap = XT + (rt * 16 + fr) * XT_PITCH + fq * 16;
                f32x4 cr[2], ci[2];
#pragma unroll
                for (int nt = 0; nt < 2; ++nt) { cr[nt] = (f32x4){0.f, 0.f, 0.f, 0.f}; ci[nt] = (f32x4){0.f, 0.f, 0.f, 0.f}; }
#pragma unroll
                for (int kh = 0; kh < 2; ++kh) { bf16x8 af[4];
#pragma unroll
                    for (int ks = 0; ks < 4; ++ks) af[ks] = *(const LAS bf16x8*)(ap + (kh * 4 + ks) * 64);
#pragma unroll
                    for (int ks = 0; ks < 4; ++ks)
#pragma unroll
                        for (int nt = 0; nt < 2; ++nt) { cr[nt] = __builtin_amdgcn_mfma_f32_16x16x32_bf16(af[ks], Br[nt][kh * 4 + ks], cr[nt], 0, 0, 0); ci[nt] = __builtin_amdgcn_mfma_f32_16x16x32_bf16(af[ks], Bi[nt][kh * 4 + ks], ci[nt], 0, 0, 0); } }
#pragma unroll
                for (int nt = 0; nt < 2; ++nt) {
                    const int d = wv * 32 + nt * 16 + fr, ch = n * 256 + d;
                    const LAS unsigned char* xp = XT + (rt * 16 + 4 * fq) * XT_PITCH + d * 2;
                    float Pl[4], Hl[4];
#pragma unroll
                    for (int jj = 0; jj < 4; ++jj) { const float xc = bf2f(*(const LAS bf16_t*)(xp + jj * XT_PITCH));
                        const float r = fast_sigmoid(cr[nt][jj] + vbr[nt]), ig = fast_sigmoid(ci[nt][jj] + vbi[nt]);
                        const float L2 = r * vc8[nt], av = __builtin_amdgcn_exp2f(L2), uv = xc * ig * __builtin_amdgcn_sqrtf(__builtin_fmaf(-av, av, 1.0f));
                        Pl[jj] = (jj == 0) ? av : Pl[jj - 1] * av; Hl[jj] = (jj == 0) ? uv : av * Hl[jj - 1] + uv; }
                    const float A0 = __shfl(Pl[3], fr), A1 = __shfl(Pl[3], fr + 16), A2 = __shfl(Pl[3], fr + 32), A3 = __shfl(Pl[3], fr + 48);
                    const float H0 = __shfl(Hl[3], fr), H1 = __shfl(Hl[3], fr + 16), H2 = __shfl(Hl[3], fr + 32), H3 = __shfl(Hl[3], fr + 48);
                    const float A01 = A1 * A0, H01 = A1 * H0 + H1, A012 = A2 * A01, H012 = A2 * H01 + H2;
                    const float Ae = fq == 0 ? 1.f : (fq == 1 ? A0 : (fq == 2 ? A01 : A012)), He = fq == 0 ? 0.f : (fq == 1 ? H0 : (fq == 2 ? H01 : H012));
                    const float At = A3 * A012, Ht = A3 * H012 + H3;
                    const float Ap = Ac[nt] * Ae, Hp = Ae * Hc[nt] + He;
                    unsigned* op = HP + (tok0 + (size_t)(rt * 16 + 4 * fq)) * BW + ch;
#pragma unroll
                    for (int jj = 0; jj < 4; ++jj) op[(size_t)jj * BW] = cvt_pk_bf16(Pl[jj] * Hp + Hl[jj], Ap * Pl[jj]);
                    Hc[nt] = At * Hc[nt] + Ht; Ac[nt] = Ac[nt] * At;
                }
            }
#pragma unroll
            for (int nt = 0; nt < 2; ++nt) if (fq == 0) { const int ch = n * 256 + wv * 32 + nt * 16 + fr; const size_t ci_ = (size_t)(b * NCHUNK + tile) * BW + ch; CARA[ci_] = Ac[nt]; CARH[ci_] = Hc[nt]; }
        }
        __syncthreads();
    }
}
__device__ __forceinline__ void p_carry(Frame& F) {
    const int lane = fresh_lane(), tid = F.wave * 64 + lane;
    const float* CARA = (const float*)F.wsp(WS_CARA); const float* CARH = (const float*)F.wsp(WS_CARH); float* CIN = (float*)F.wsp(WS_CIN);
    if (tid < 32) {
        for (int task = blockIdx.x * 32 + tid; task < NBATCH * BW; task += F.G * 32) { const int b = task >> 11, ch = task & (BW - 1);
            float hin = 0.f;
#pragma unroll 8
            for (int c = 0; c < NCHUNK; ++c) { const size_t idx = (size_t)(b * NCHUNK + c) * BW + ch; CIN[idx] = hin; hin = CARA[idx] * hin + CARH[idx]; } }
    }
}

__device__ __forceinline__ void p_attention2(Frame& F, char* lds) {
    const bf16_t* P = (const bf16_t*)F.wsp(WS_PROJ); bf16_t* OB = (bf16_t*)F.wsp(WS_OB);
    constexpr int TOTAL = NBATCH * 8 * 2 * 8;
    for (int L = blockIdx.x; L < TOTAL; L += F.G) {
        const int k = (L & 255) >> 3, g = (L >> 8) * 16 + (L & 7) * 2 + (k >> 4), sub = k & 15, comp = sub >> 3, y = sub & 7;
        const int b = g >> 3, h = g & 7; const size_t tok0 = (size_t)b * SEQ;
#pragma unroll 1
        for (int pass = 0; pass < 2; ++pass) { const int qb = pass ? (15 - y) : y;
            att::BlockRef2 r;
            r.Q = P + PLO(COL_Q) + (tok0 + (size_t)qb * att::QB) * PP + h * 256 + comp * 128;
            r.K = P + PLO(COL_K) + tok0 * PP + h * 256 + comp * 128;
            r.V = P + PLO(COL_V) + tok0 * PP + h * 256;
            r.O = OB + (tok0 + (size_t)qb * att::QB) * DM + h * 512 + comp * 256;
            r.P0 = qb * att::QB;
            att::causal_block2(r, lds); }
    }
}

__device__ __forceinline__ void p_post(Frame& F, int l) {
    const int lane = fresh_lane(), gt = F.gw * 64 + lane;
    const bf16_t* P = (const bf16_t*)F.wsp(WS_PROJ); const unsigned* HP = (const unsigned*)F.wsp(WS_HL);
    const float* CIN = (const float*)F.wsp(WS_CIN); const bf16_t* OB = (const bf16_t*)F.wsp(WS_OB); bf16_t* Y = (bf16_t*)F.wsp(WS_Y);
    for (int task0 = gt; task0 < MTOK * (BW / 8); task0 += 4 * F.NGT) {
        u32x4 h0[4], h1[4], sgw[4]; f32x4 c0[4], c1[4];
#pragma unroll
        for (int k = 0; k < 4; ++k) { const int task = task0 + k * F.NGT; if (task < MTOK * (BW / 8)) { const int cg = task & 255, row = task >> 8, ch = cg * 8, chunk = row / CHUNK;
            h0[k] = *(const u32x4*)(HP + (size_t)row * BW + ch); h1[k] = *(const u32x4*)(HP + (size_t)row * BW + ch + 4); sgw[k] = *(const u32x4*)(P + PLO(COL_AG) + (size_t)row * PP + ch);
            c0[k] = *(const f32x4*)(CIN + (size_t)chunk * BW + ch); c1[k] = *(const f32x4*)(CIN + (size_t)chunk * BW + ch + 4); } }
#pragma unroll
        for (int k = 0; k < 4; ++k) { const int task = task0 + k * F.NGT; if (task < MTOK * (BW / 8)) { const int cg = task & 255, row = task >> 8, ch = cg * 8;
            float sg[8], yo[8]; unpack8(sgw[k], sg);
#pragma unroll
            for (int q = 0; q < 8; ++q) sg[q] = fast_silu(sg[q]);
#pragma unroll
            for (int q = 0; q < 4; ++q) { yo[q] = (bf_lo(h0[k][q]) + bf_hi(h0[k][q]) * c0[k][q]) * sg[q]; yo[4 + q] = (bf_lo(h1[k][q]) + bf_hi(h1[k][q]) * c1[k][q]) * sg[4 + q]; }
            *(u32x4*)(Y + (size_t)row * YW + ch) = pack8f(yo); } }
    }
    { const float* ccwp = F.fin(I_CONV_C_W) + (size_t)l * 3 * BW;
      constexpr int RUN = 32, NTASK = (MTOK / RUN) * (BW / 8);
      for (int task = gt; task < NTASK; task += F.NGT) {
        const int cg = task & 255, run = task >> 8, t0 = run * RUN, ch = cg * 8;
        float ccw[3][8];
#pragma unroll
        for (int j = 0; j < 3; ++j) { const f32x4 a = *(const f32x4*)(ccwp + (size_t)j * BW + ch), b = *(const f32x4*)(ccwp + (size_t)j * BW + ch + 4);
#pragma unroll
            for (int q = 0; q < 4; ++q) { ccw[j][q] = a[q]; ccw[j][4 + q] = b[q]; } }
        float p1[8], p2[8];
#pragma unroll
        for (int q = 0; q < 8; ++q) { p1[q] = 0.f; p2[q] = 0.f; }
        if ((t0 & (SEQ - 1)) != 0) {
            const bf16_t* r2 = P + (size_t)(t0 - 2) * PP; const bf16_t* r1 = P + (size_t)(t0 - 1) * PP;
            float c2[8], x2[8], c1[8], x1[8];
            unpack8(*(const u32x4*)(r2 + PLO(COL_CC) + ch), c2); unpack8(*(const u32x4*)(r2 + PLO(COL_CX) + ch), x2); unpack8(*(const u32x4*)(r1 + PLO(COL_CC) + ch), c1); unpack8(*(const u32x4*)(r1 + PLO(COL_CX) + ch), x1);
#pragma unroll
            for (int q = 0; q < 8; ++q) { p2[q] = c2[q] * x2[q]; p1[q] = c1[q] * x1[q]; }
        }
#pragma unroll 4
        for (int r = 0; r < RUN; ++r) { const int t = t0 + r; const bf16_t* rp = P + (size_t)t * PP;
            float cc0[8], cx0[8], cb0[8], cg0[8];
            unpack8(*(const u32x4*)(rp + PLO(COL_CC) + ch), cc0); unpack8(*(const u32x4*)(rp + PLO(COL_CX) + ch), cx0); unpack8(*(const u32x4*)(rp + PLO(COL_CB) + ch), cb0); unpack8(*(const u32x4*)(rp + PLO(COL_CG) + ch), cg0);
            float yo[8];
#pragma unroll
            for (int q = 0; q < 8; ++q) { const float p0 = cc0[q] * cx0[q]; yo[q] = cb0[q] * (ccw[0][q] * p2[q] + ccw[1][q] * p1[q] + ccw[2][q] * p0) * fast_silu(cg0[q]); p2[q] = p1[q]; p1[q] = p0; }
            *(u32x4*)(Y + (size_t)t * YW + 2 * BW + ch) = pack8f(yo); }
      }
    }
    const float lam_init = 0.8f - 0.6f * expf(-0.3f * (float)l);
    const float* lq1 = F.fin(I_LQ1) + l * 128; const float* lk1 = F.fin(I_LK1) + l * 128; const float* lq2 = F.fin(I_LQ2) + l * 128; const float* lk2 = F.fin(I_LK2) + l * 128;
    float s1 = lq1[lane] * lk1[lane] + lq1[64 + lane] * lk1[64 + lane];
    float s2 = lq2[lane] * lk2[lane] + lq2[64 + lane] * lk2[64 + lane];
    s1 = wave_sum(s1); s2 = wave_sum(s2);
    const float lam = expf(s1) - expf(s2) + lam_init;
    const int e = lane * 4;
    const f32x4 sw = *(const f32x4*)(F.fin(I_SUBLN) + l * 256 + e);
    const float post = 1.0f - lam_init;
    for (int row = F.gwo(); row < MTOK; row += F.NGW) {
        u32x2 w0[8], w1[8], wg[8];
#pragma unroll
        for (int h = 0; h < 8; ++h) { w0[h] = *(const u32x2*)(OB + (size_t)row * DM + h * 512 + e); w1[h] = *(const u32x2*)(OB + (size_t)row * DM + h * 512 + 256 + e);
            wg[h] = *(const u32x2*)(P + PLO(COL_BG) + (size_t)row * PP + h * 256 + e); }
        f32x4 d[8]; float ss[8];
#pragma unroll
        for (int h = 0; h < 8; ++h) { d[h].x = bf_lo(w0[h].x) - lam * bf_lo(w1[h].x); d[h].y = bf_hi(w0[h].x) - lam * bf_hi(w1[h].x); d[h].z = bf_lo(w0[h].y) - lam * bf_lo(w1[h].y); d[h].w = bf_hi(w0[h].y) - lam * bf_hi(w1[h].y);
            ss[h] = (d[h].x * d[h].x + d[h].y * d[h].y) + (d[h].z * d[h].z + d[h].w * d[h].w); }
#pragma unroll
        for (int o = 1; o < 64; o <<= 1) {
#pragma unroll
            for (int h = 0; h < 8; ++h) ss[h] += __shfl_xor(ss[h], o); }
#pragma unroll
        for (int h = 0; h < 8; ++h) { const float rs = post * __builtin_amdgcn_rsqf(ss[h] * (1.0f / 256.0f) + 1e-5f);
            u32x2 o; o.x = cvt_pk_bf16(d[h].x * rs * sw.x * fast_silu(bf_lo(wg[h].x)), d[h].y * rs * sw.y * fast_silu(bf_hi(wg[h].x))); o.y = cvt_pk_bf16(d[h].z * rs * sw.z * fast_silu(bf_lo(wg[h].y)), d[h].w * rs * sw.w * fast_silu(bf_hi(wg[h].y)));
            *(u32x2*)(Y + (size_t)row * YW + BW + h * 256 + e) = o; }
    }
}

constexpr int NP = 7;
constexpr int N_PHASES = 2 + DEPTH * NP + 1;
struct Args { const void* in[21]; float* out; unsigned char* ws; int ph_lo, ph_hi; };
__global__ void __launch_bounds__(NWAVES * 64, 2) trunk_fwd(Args args) {
    extern __shared__ __attribute__((aligned(16))) unsigned char lds[];
    Frame F;
    F.lds = (LAS unsigned char*)lds;
    const int tid = threadIdx.x; F.wave = __builtin_amdgcn_readfirstlane(tid >> 6);
    F.G = gridDim.x; { const int bx = blockIdx.x; F.vcu = (F.G % 8 == 0) ? (bx % 8) * (F.G / 8) + bx / 8 : bx; }
    F.gw = F.vcu * NWAVES + F.wave; F.NGW = F.G * NWAVES; F.NGT = F.NGW * 64;
    F.ws = args.ws; F.out = args.out;
    F.in = args.in;
    for (int u = tid; u < (LDS_BYTES - LDSCTL_OFF) / 4; u += NWAVES * 64) ((LAS unsigned*)(F.lds + LDSCTL_OFF))[u] = 0u;
    __syncthreads();
    unsigned* ctl = (unsigned*)(args.ws + WS_CTL);
    const int lo = args.ph_lo, hi = args.ph_hi;
    XcdBarrier bar; bar.bar = ctl + CW_BAR; bar.x = 0; bar.st = nullptr;
    if (hi - lo > 1) bar = xcd_barrier_post(ctl + CW_BAR, (volatile LAS unsigned*)(F.lds + MISC_OFF) + 8);
#define IN(k) (lo <= (k) && (k) < hi)
#define SEAM(k) do { if (IN((k) + 1)) { xcd_barrier(bar); if (PH_REP(11) > 1) xcd_barrier(bar); } } while (0)

    if (IN(0)) { if constexpr (PH_ON(0)) for (int rep = 0; rep < PH_REP(0); ++rep) { p_wquant_fused(F); p_prologue(F); } SEAM(0); }

    if (IN(1)) { SEAM(1); }

    for (int l = 0; l < DEPTH; ++l) {
        const int pb = 2 + l * NP;
        if (IN(pb + 0)) { if constexpr (PH_ON(1)) for (int rep = 0; rep < PH_REP(1); ++rep) {
            if (l == 0) p_rmsnorm_bf16<true>(F, F.fin(I_X), F.fin(I_NORM_W), (bf16_t*)F.wsp(WS_H));
            else p_rmsnorm_bf16<false>(F, F.wsp((l & 1) ? WS_XB : WS_XB1), F.fin(I_NORM_W) + (size_t)l * DM, (bf16_t*)F.wsp(WS_H)); }
            SEAM(pb + 0); }
        if (IN(pb + 1)) { if constexpr (PH_ON(2)) for (int rep = 0; rep < PH_REP(2); ++rep) {
            pg8::Gemm g{(const bf16_t*)F.wsp(WS_H), (const bf16_t*)F.wsp(WS_WIN) + (size_t)l * INC * DM, DM, DM, DM}; pg8::Order<4, WG_P> S; S.init(MTOK, NB_TILES * 256, F.G, (int)blockIdx.x);
            pg8::EpiProj E{(bf16_t*)F.wsp(WS_PROJ), F.fin(I_GATE_B) + (size_t)l * 3 * DM, (const int*)F.fin(I_POS), nullptr, nullptr};
            pg8::gemm_phase<pg8::EpiProj, pg8::Order<4, WG_P>>(F.lds + RING_OFF, g, S, E); }
            SEAM(pb + 1);
        }
        if (IN(pb + 2)) { if constexpr (PH_ON(4)) for (int rep = 0; rep < PH_REP(4); ++rep) {
            pg8::Gemm g{(const bf16_t*)F.wsp(WS_HQ), (const bf16_t*)F.wsp(WS_WQ) + (size_t)l * INC * (DM / 2), DM / 2, DM / 2, DM / 2}; pg8::Order<3, WG_Q> S; S.init(MTOK, NQ_TILES * 256, F.G, (int)blockIdx.x);
            pg8::EpiProj E{(bf16_t*)F.wsp(WS_PROJ), F.fin(I_GATE_B) + (size_t)l * 3 * DM, (const int*)F.fin(I_POS), (const float*)F.wsp(WS_SA), (const float*)F.wsp(WS_SW) + (size_t)l * INC};
            pg8::gemm_phase<pg8::EpiProj, pg8::Order<3, WG_Q>, true, true, true>(F.lds + RING_OFF, g, S, E); }
            if constexpr (PH_ON(3)) for (int rep = 0; rep < PH_REP(3); ++rep) p_lru(F, l);
            SEAM(pb + 2);
        }
        if (IN(pb + 3)) { if constexpr (PH_ON(6)) for (int rep = 0; rep < PH_REP(6); ++rep) { p_carry(F); p_attention2(F, (char*)lds + RING_OFF); } SEAM(pb + 3); }
        if (IN(pb + 4)) { if constexpr (PH_ON(7)) for (int rep = 0; rep < PH_REP(7); ++rep) p_post(F, l); SEAM(pb + 4); }
        if (IN(pb + 5)) { if constexpr (PH_ON(8)) for (int rep = 0; rep < PH_REP(8); ++rep) {
            pg8::Gemm g{(const bf16_t*)F.wsp(WS_Y), (const bf16_t*)F.wsp(WS_WB) + (size_t)l * DM * YW, YW, YW, BW}; pg8::Order<2, WG_B> S; S.init(MTOK, DM, F.G, (int)blockIdx.x);
            pg8::EpiMerge E{(bf16_t*)F.wsp(WS_MG), (const bf16_t*)F.wsp(WS_PROJ)};
            pg8::gemm_phase<pg8::EpiMerge, pg8::Order<2, WG_B>>(F.lds + RING_OFF, g, S, E); }
            SEAM(pb + 5);
        }
        if (IN(pb + 6)) { if constexpr (PH_ON(9)) for (int rep = 0; rep < PH_REP(9); ++rep) {
            pg8::Gemm g{(const bf16_t*)F.wsp(WS_MG), (const bf16_t*)F.wsp(WS_WO) + (size_t)l * DM * DM, DM, DM, DM}; pg8::Order<0, WG_O> S; S.init(MTOK, DM, F.G, (int)blockIdx.x);
            if (l == 0) { pg8::EpiOut<true> E{F.fin(I_X), (bf16_t*)F.wsp(WS_XB)}; pg8::gemm_phase<pg8::EpiOut<true>, pg8::Order<0, WG_O>>(F.lds + RING_OFF, g, S, E); }
            else { pg8::EpiOut<false> E{F.wsp((l & 1) ? WS_XB : WS_XB1), (bf16_t*)F.wsp((l & 1) ? WS_XB1 : WS_XB)}; pg8::gemm_phase<pg8::EpiOut<false>, pg8::Order<0, WG_O>>(F.lds + RING_OFF, g, S, E); } }
            SEAM(pb + 6);
        }
    }
    if (IN(N_PHASES - 1)) { if constexpr (PH_ON(10)) p_rmsnorm_f32(F, (const bf16_t*)F.wsp(((DEPTH - 1) & 1) ? WS_XB1 : WS_XB), F.fin(I_FINAL_W), F.out); }
#undef IN
#undef SEAM
}

extern "C" void kernel_launch(void* const* d_in, const int* in_sizes, int n_in, void* d_out, int out_size, void* d_ws, size_t ws_size, hipStream_t stream) {
    static int grid = 0;
    if (grid == 0) {
        if (n_in != 21 || in_sizes[0] != MTOK * DM || out_size != MTOK * DM || ws_size < WS_END) { fprintf(stderr, "kernel_launch: unexpected shapes (n_in %d, in0 %d, out %d, ws %zu)\n", n_in, n_in > 0 ? in_sizes[0] : -1, out_size, ws_size); grid = -1; return; }
        int dev = 0, cus = 0, per_cu = 0;
        if (hipGetDevice(&dev) != hipSuccess || hipDeviceGetAttribute(&cus, hipDeviceAttributeMultiprocessorCount, dev) != hipSuccess) { grid = -1; return; }
        if (hipFuncSetAttribute((const void*)trunk_fwd, hipFuncAttributeMaxDynamicSharedMemorySize, LDS_BYTES) != hipSuccess) { fprintf(stderr, "kernel_launch: hipFuncSetAttribute failed\n"); grid = -1; return; }
        if (hipOccupancyMaxActiveBlocksPerMultiprocessor(&per_cu, (const void*)trunk_fwd, NWAVES * 64, LDS_BYTES) != hipSuccess || per_cu < 1) fprintf(stderr, "kernel_launch: occupancy query reports %d\n", per_cu);
        (void)hipGetLastError();
        grid = cus;
    }
    if (grid < 0) return;
    if (hipMemsetAsync((char*)d_ws + WS_CTL, 0, CTL_ZERO_BYTES, stream) != hipSuccess) return;
    Args a{};
    for (int i = 0; i < 21; ++i) a.in[i] = d_in[i];
    a.out = (float*)d_out; a.ws = (unsigned char*)d_ws;
#if MK_N_LAUNCHES == 1
    a.ph_lo = 0; a.ph_hi = N_PHASES;
    hipLaunchKernelGGL(trunk_fwd, dim3(grid), dim3(NWAVES * 64), LDS_BYTES, stream, a);
#else
    for (int p = 0; p < N_PHASES; ++p) { a.ph_lo = p; a.ph_hi = p + 1; hipLaunchKernelGGL(trunk_fwd, dim3(grid), dim3(NWAVES * 64), LDS_BYTES, stream, a); }
#endif
}
```

```cpp
#include <hip/hip_runtime.h>
#include <cstdio>
#include <cstdint>

#ifndef MK_N_LAUNCHES
#define MK_N_LAUNCHES 1
#endif
#ifndef MK_DBG
#define MK_DBG 0
#endif
#ifndef PH_MASK
#define PH_MASK 0xFFFF
#endif
#define PH_ON(b) ((PH_MASK >> (b)) & 1)
#ifndef DUP_MASK
#define DUP_MASK 0
#endif
#ifndef WG_P
#define WG_P 4
#endif
#ifndef WG_Q
#define WG_Q 4
#endif
#ifndef WG_B
#define WG_B 4
#endif
#ifndef WG_O
#define WG_O 4
#endif
#define PH_REP(b) (1 + ((DUP_MASK >> (b)) & 1))

#define LAS __attribute__((address_space(3)))
#define GAS __attribute__((address_space(1)))
typedef unsigned short bf16_t;
typedef short bf16x8 __attribute__((ext_vector_type(8)));
typedef short s16x4 __attribute__((ext_vector_type(4)));
typedef float f32x4 __attribute__((ext_vector_type(4)));
typedef float f32x16 __attribute__((ext_vector_type(16)));
typedef unsigned u32x4 __attribute__((ext_vector_type(4)));
typedef unsigned u32x2 __attribute__((ext_vector_type(2)));
typedef float f32x2 __attribute__((ext_vector_type(2)));
typedef int i32x4 __attribute__((ext_vector_type(4)));

constexpr int DM = 4096, NBATCH = 4, SEQ = 4096, DEPTH = 4, MTOK = NBATCH * SEQ;
constexpr int BW = 2048, INC = 32768;
constexpr int COL_AX = 0, COL_AG = 2048, COL_Q = 4096, COL_K = 6144, COL_V = 8192, COL_BG = 10240, COL_CB = 12288, COL_CC = 14336, COL_CX = 16384, COL_CG = 18432, COL_GL = 20480;
constexpr int YW = 3 * BW;
constexpr int PP = 2048; constexpr size_t PLANE = (size_t)MTOK * PP;
#define PLO(col) ((size_t)((col) >> 11) * PLANE)
constexpr int NGATE = 3 * DM;
constexpr int NQ_TILES = 104, NB_TILES = INC / 256 - NQ_TILES;
__host__ __device__ constexpr int q_tile(int q) { return q < 40 ? 8 + q : 24 + q; }
__host__ __device__ constexpr int b_tile(int p) { return p < 8 ? p : p + 40; }
constexpr int CHUNK = 128, NCHUNK = SEQ / CHUNK;

__device__ __forceinline__ unsigned cvt_pk_bf16(float lo, float hi) { unsigned r; asm volatile("v_cvt_pk_bf16_f32 %0, %1, %2" : "=v"(r) : "v"(lo), "v"(hi)); return r; }
__device__ __forceinline__ float bf_lo(unsigned w) { return __uint_as_float(w << 16); }
__device__ __forceinline__ float bf_hi(unsigned w) { return __uint_as_float(w & 0xffff0000u); }
__device__ __forceinline__ float bf2f(bf16_t b) { return __uint_as_float(((unsigned)b) << 16); }
__device__ __forceinline__ void unpack8(const u32x4 w, float (&f)[8]) { f[0] = bf_lo(w.x); f[1] = bf_hi(w.x); f[2] = bf_lo(w.y); f[3] = bf_hi(w.y); f[4] = bf_lo(w.z); f[5] = bf_hi(w.z); f[6] = bf_lo(w.w); f[7] = bf_hi(w.w); }
__device__ __forceinline__ u32x4 pack8f(const float (&f)[8]) { u32x4 w; w.x = cvt_pk_bf16(f[0], f[1]); w.y = cvt_pk_bf16(f[2], f[3]); w.z = cvt_pk_bf16(f[4], f[5]); w.w = cvt_pk_bf16(f[6], f[7]); return w; }
__device__ __forceinline__ float fast_sigmoid(float x) { return __builtin_amdgcn_rcpf(1.0f + __builtin_amdgcn_exp2f(-1.4426950408889634f * x)); }
__device__ __forceinline__ float fast_silu(float x) { return x * fast_sigmoid(x); }
__device__ __forceinline__ float wave_sum(float v) {
#pragma unroll
    for (int o = 1; o < 64; o <<= 1) v += __shfl_xor(v, o);
    return v;
}
__device__ __forceinline__ float one_minus_a2(float L2) {
    const float y = 1.3862943611198906f * L2;
    if (y > -0.1f) { float p = 1.0f / 120.0f; p = p * y + 1.0f / 24.0f; p = p * y + 1.0f / 6.0f; p = p * y + 0.5f; p = p * y + 1.0f; return -y * p; }
    return 1.0f - __builtin_amdgcn_exp2f(2.0f * L2);
}

__device__ __forceinline__ int fresh_lane() { int l; asm volatile("v_mbcnt_lo_u32_b32 %0, -1, 0\n\tv_mbcnt_hi_u32_b32 %0, -1, %0" : "=v"(l)); return l; }

namespace pg8 {
constexpr int BM = 256, BK = 64, HALF = 128, HTB = HALF * BK * 2, STAGE_BYTES = 8 * HTB, NXCD = 8, WGM = 4;
__host__ __device__ __forceinline__ int lds_byte(int r, int c) { const int st = (r >> 4) * 2 + (c >> 5), rr = r & 15, cc = c & 31, ob = rr * 64 + cc * 2; return st * 1024 + (ob ^ (((ob >> 9) & 1) << 5)); }
__host__ __device__ __forceinline__ void stage_rc(int b, int& R, int& C) { const int st = b / 1024, sb = b % 1024, swz = sb ^ (((sb >> 9) & 1) << 5); R = (st >> 1) * 16 + swz / 64; C = (st & 1) * 32 + (swz % 64) / 2; }
__host__ __device__ __forceinline__ int perm32(int rho) { const int n = rho >> 4, i = rho & 15; return 8 * (i >> 2) + 4 * n + (i & 3); }

struct Unit { int pm, pn, ka, kb, j; };
struct Gemm { const bf16_t* A; const bf16_t* Bt; int lda, ldb, K; };

template <int MODE, int WG = WGM> struct Order {
    int nM, nN, nwg, G, c;
    __device__ void init(int Mr, int N, int G_, int c_) { nM = Mr / BM; nN = N / BM; nwg = nM * nN; G = G_; c = c_; }
    __device__ bool next(int i, Unit& u) const {
        const int it = (MODE == 2) ? i / 3 : i; const int j = (MODE == 2) ? i - 3 * it : 0;
        const long L = (long)it * G + c; if (L >= nwg) return false;
        int wgid = (int)L; { const int q = nwg / NXCD, r = nwg % NXCD, xcd = wgid % NXCD, off = wgid / NXCD; wgid = (xcd < r ? xcd * (q + 1) : r * (q + 1) + (xcd - r) * q) + off; }
        const int nig = WG * nN, gid = wgid / nig, fm = gid * WG, gsz = (nM - fm) < WG ? (nM - fm) : WG;
        u.pm = fm + ((wgid % nig) % gsz); u.pn = (wgid % nig) / gsz; u.j = j;
        if (MODE == 1) { u.ka = (u.pn >> 1) * 256; u.kb = 0; }
        else if (MODE == 2) { u.ka = j * BW; u.kb = j * BW; }
        else { u.ka = 0; u.kb = 0; }
        if (MODE == 3) u.pn = q_tile(u.pn); else if (MODE == 4) u.pn = b_tile(u.pn);
        return true;
    }
};

template <bool I8> struct AccT { typedef f32x4 type; };
template <> struct AccT<true> { typedef i32x4 type; };
template <class Epi, class Sched, bool ALIGN_EPI = true, bool SP2 = true, bool I8 = false>
__device__ __forceinline__ void gemm_phase(LAS unsigned char* lds, const Gemm g, const Sched& S, const Epi& E) {
    const int wid = __builtin_amdgcn_readfirstlane(threadIdx.x >> 6), lane = fresh_lane(), tid = wid * 64 + lane, wr = wid >> 2, wc = wid & 3, fr = lane & 15, fq = lane >> 4;
    const int K = g.K, nt = K / BK;
    unsigned voffA[2], voffB[2];
#pragma unroll
    for (int i = 0; i < 2; ++i) { int R, C; stage_rc(tid * 16 + i * 8192, R, C);
        int Rb;
        if (Epi::BPERM == 0) Rb = R; else if (Epi::BPERM == 1) Rb = (R & ~31) + perm32(R & 31); else Rb = (R >> 6) * 128 + ((R >> 5) & 1) * 32 + perm32(R & 31);
        voffA[i] = (unsigned)(R * g.lda + C) * 2u; voffB[i] = (unsigned)(Rb * g.ldb + C) * 2u; }
    const size_t kstep = (size_t)(BK * 2);
    const size_t hstepA = (size_t)HALF * g.lda * 2, hstepB = (size_t)(Epi::BPERM == 2 ? 64 : HALF) * g.ldb * 2;
    const size_t tstepA = (size_t)BM * g.lda * 2, tstepB = (size_t)BM * g.ldb * 2;
    const unsigned ldsw = (unsigned)wid * 1024u;
    const int aoff = lds_byte(wr * 64 + fr, fq * 8), boff = lds_byte(wc * 32 + fr, fq * 8);
#define PG8_SA(b, h) (((b) * 2 + (h)) * HTB)
#define PG8_SB(b, h) ((4 + (b) * 2 + (h)) * HTB)
#define PG8_STAGE(bufoff, gbase, voff) do { _Pragma("unroll") for (int _i = 0; _i < 2; ++_i) \
        __builtin_amdgcn_global_load_lds((const unsigned*)((const char*)(gbase) + (voff)[_i]), (LAS unsigned*)(lds + (bufoff) + ldsw + _i * 8192), 16, 0, 0); } while (0)
#define PG8_LDA(dst, b, h) do { _Pragma("unroll") for (int m = 0; m < 4; ++m) _Pragma("unroll") for (int k = 0; k < 2; ++k) dst[m][k] = *(const LAS bf16x8*)(lds + PG8_SA(b, h) + aoff + m * 2048 + k * 1024); } while (0)
#define PG8_LDB(dst, b, h) do { _Pragma("unroll") for (int n = 0; n < 2; ++n) _Pragma("unroll") for (int k = 0; k < 2; ++k) dst[n][k] = *(const LAS bf16x8*)(lds + PG8_SB(b, h) + boff + n * 2048 + k * 1024); } while (0)
#define PG8_MMA(ai, bj, At, Bt) do { __builtin_amdgcn_s_setprio(1); \
        if constexpr (I8) { _Pragma("unroll") for (int k = 0; k < 2; ++k) _Pragma("unroll") for (int m = 0; m < 4; ++m) _Pragma("unroll") for (int n = 0; n < 2; ++n)     \
            acc[ai][bj][m][n] = __builtin_amdgcn_mfma_i32_16x16x64_i8(__builtin_bit_cast(i32x4, Bt[n][k]), __builtin_bit_cast(i32x4, At[m][k]), acc[ai][bj][m][n], 0, 0, 0); } \
        else { _Pragma("unroll") for (int m = 0; m < 4; ++m) _Pragma("unroll") for (int n = 0; n < 2; ++n) _Pragma("unroll") for (int k = 0; k < 2; ++k) \
            acc[ai][bj][m][n] = __builtin_amdgcn_mfma_f32_16x16x32_bf16(Bt[n][k], At[m][k], acc[ai][bj][m][n], 0, 0, 0); } \
        __builtin_amdgcn_s_setprio(0); } while (0)
#define PG8_WAIT_V(n) asm volatile("s_waitcnt vmcnt(" #n ")" ::: "memory")
#define PG8_WAIT_L(n) asm volatile("s_waitcnt lgkmcnt(" #n ")" ::: "memory")
#define PG8_BAR __builtin_amdgcn_s_barrier()
#define PG8_SCHED __builtin_amdgcn_sched_barrier(0)
    Unit cur, nxt; int ui = 0;
    if (!S.next(0, cur)) return;
    typedef typename AccT<I8>::type acc_t;
    acc_t acc[2][2][4][2];
#pragma unroll
    for (int a = 0; a < 2; ++a)
#pragma unroll
        for (int b = 0; b < 2; ++b)
#pragma unroll
            for (int m = 0; m < 4; ++m)
#pragma unroll
                for (int n = 0; n < 2; ++n) acc[a][b][m][n] = (acc_t){0, 0, 0, 0};
    bf16x8 At[4][2], B0[2][2], B1[2][2];
    const char* cA = (const char*)g.A + (size_t)cur.pm * tstepA + (size_t)cur.ka * 2; const char* cB = (const char*)g.Bt + (size_t)cur.pn * tstepB + (size_t)cur.kb * 2;
    if constexpr (SP2) {
        PG8_STAGE(PG8_SB(0, 0), cB, voffB); PG8_STAGE(PG8_SB(0, 1), cB + hstepB, voffB); PG8_STAGE(PG8_SA(0, 0), cA, voffA); PG8_STAGE(PG8_SA(0, 1), cA + hstepA, voffA);
        if (wr == 1) PG8_BAR;
        PG8_WAIT_V(2); PG8_BAR;
        PG8_STAGE(PG8_SB(1, 0), cB + kstep, voffB); PG8_STAGE(PG8_SA(1, 0), cA + kstep, voffA); PG8_STAGE(PG8_SB(1, 1), cB + hstepB + kstep, voffB);
        PG8_WAIT_V(6); PG8_BAR;
    } else {
        PG8_STAGE(PG8_SB(0, 0), cB, voffB); PG8_STAGE(PG8_SA(0, 0), cA, voffA); PG8_STAGE(PG8_SB(0, 1), cB + hstepB, voffB); PG8_STAGE(PG8_SA(0, 1), cA + hstepA, voffA);
        if (wr == 1) PG8_BAR;
        PG8_WAIT_V(4); PG8_BAR;
        PG8_STAGE(PG8_SB(1, 0), cB + kstep, voffB); PG8_STAGE(PG8_SA(1, 0), cA + kstep, voffA); PG8_STAGE(PG8_SB(1, 1), cB + hstepB + kstep, voffB);
        PG8_WAIT_V(6); PG8_BAR;
    }
    for (;;) {
        const bool has_next = S.next(ui + 1, nxt);
        const char* nA = has_next ? (const char*)g.A + (size_t)nxt.pm * tstepA + (size_t)nxt.ka * 2 : cA; const char* nB = has_next ? (const char*)g.Bt + (size_t)nxt.pn * tstepB + (size_t)nxt.kb * 2 : cB;
#pragma unroll 1
        for (int t = 0; t < nt; t += 2) {
            const bool last = (t == nt - 2);
            const char* a1 = cA + (size_t)(t + 1) * kstep;
            const char* a2 = last ? nA : cA + (size_t)(t + 2) * kstep; const char* b2 = last ? nB : cB + (size_t)(t + 2) * kstep;
            const char* a3 = a2 + kstep; const char* b3 = b2 + kstep;
            if constexpr (SP2) {
            PG8_LDB(B0, 0, 0); PG8_LDB(B1, 0, 1); PG8_SCHED; PG8_LDA(At, 0, 0); PG8_STAGE(PG8_SA(1, 1), a1 + hstepA, voffA);
            PG8_WAIT_V(8); PG8_WAIT_L(0); PG8_BAR; PG8_MMA(0, 0, At, B0); PG8_MMA(0, 1, At, B1); PG8_BAR; PG8_SCHED;
            PG8_LDA(At, 0, 1); PG8_STAGE(PG8_SB(0, 0), b2, voffB); PG8_STAGE(PG8_SB(0, 1), b2 + hstepB, voffB); PG8_STAGE(PG8_SA(0, 0), a2, voffA);
            PG8_WAIT_V(8); PG8_WAIT_L(0); PG8_BAR; PG8_MMA(1, 0, At, B0); PG8_MMA(1, 1, At, B1); PG8_BAR; PG8_SCHED;
            PG8_LDB(B0, 1, 0); PG8_LDB(B1, 1, 1); PG8_SCHED; PG8_LDA(At, 1, 0); PG8_STAGE(PG8_SA(0, 1), a2 + hstepA, voffA);
            PG8_WAIT_V(8); PG8_WAIT_L(0); PG8_BAR; PG8_MMA(0, 0, At, B0); PG8_MMA(0, 1, At, B1); PG8_BAR; PG8_SCHED;
            PG8_LDA(At, 1, 1); PG8_STAGE(PG8_SB(1, 0), b3, voffB); PG8_STAGE(PG8_SB(1, 1), b3 + hstepB, voffB); PG8_STAGE(PG8_SA(1, 0), a3, voffA);
            PG8_WAIT_V(8); PG8_WAIT_L(0); PG8_BAR; PG8_MMA(1, 0, At, B0); PG8_MMA(1, 1, At, B1); PG8_BAR; PG8_SCHED;
            } else {
            PG8_LDB(B0, 0, 0); PG8_SCHED; PG8_LDA(At, 0, 0); PG8_STAGE(PG8_SA(1, 1), a1 + hstepA, voffA);
            PG8_WAIT_L(8); PG8_BAR; PG8_WAIT_L(0); PG8_MMA(0, 0, At, B0); PG8_BAR; PG8_SCHED;
            PG8_LDB(B1, 0, 1); PG8_STAGE(PG8_SB(0, 0), b2, voffB);
            PG8_BAR; PG8_WAIT_L(0); PG8_MMA(0, 1, At, B1); PG8_BAR;
            PG8_LDA(At, 0, 1); PG8_STAGE(PG8_SA(0, 0), a2, voffA);
            PG8_BAR; PG8_WAIT_L(0); PG8_MMA(1, 0, At, B0); PG8_BAR; PG8_SCHED;
            PG8_STAGE(PG8_SB(0, 1), b2 + hstepB, voffB);
            PG8_WAIT_V(6); PG8_BAR; PG8_MMA(1, 1, At, B1); PG8_BAR;
            PG8_LDB(B0, 1, 0); PG8_SCHED; PG8_LDA(At, 1, 0); PG8_STAGE(PG8_SA(0, 1), a2 + hstepA, voffA);
            PG8_WAIT_L(8); PG8_BAR; PG8_WAIT_L(0); PG8_MMA(0, 0, At, B0); PG8_BAR; PG8_SCHED;
            PG8_LDB(B1, 1, 1); PG8_STAGE(PG8_SB(1, 0), b3, voffB);
            PG8_BAR; PG8_WAIT_L(0); PG8_MMA(0, 1, At, B1); PG8_BAR;
            PG8_LDA(At, 1, 1); PG8_STAGE(PG8_SA(1, 0), a3, voffA);
            PG8_BAR; PG8_WAIT_L(0); PG8_MMA(1, 0, At, B0); PG8_BAR; PG8_SCHED;
            PG8_STAGE(PG8_SB(1, 1), b3 + hstepB, voffB);
            PG8_WAIT_V(6); PG8_BAR; PG8_MMA(1, 1, At, B1); PG8_BAR;
            }
        }
        if constexpr (ALIGN_EPI) { if (wr == 0) PG8_BAR; }
        const int lz = fresh_lane();
        const bool fin = E(acc, cur, wr, wc, lz & 15, lz >> 4);
        if (!has_next) break;
        if (fin) {
#pragma unroll
        for (int a = 0; a < 2; ++a)
#pragma unroll
            for (int b = 0; b < 2; ++b)
#pragma unroll
                for (int m = 0; m < 4; ++m)
#pragma unroll
                    for (int n = 0; n < 2; ++n) acc[a][b][m][n] = (acc_t){0, 0, 0, 0};
        }
        cur = nxt; cA = nA; cB = nB; ++ui;
        if constexpr (ALIGN_EPI) { if (wr == 1) PG8_BAR; }
    }
    PG8_WAIT_V(0);
    if constexpr (!ALIGN_EPI) { if (wr == 0) PG8_BAR; }
    PG8_BAR;
#undef PG8_SA
#undef PG8_SB
#undef PG8_STAGE
#undef PG8_LDA
#undef PG8_LDB
#undef PG8_MMA
#undef PG8_WAIT_V
#undef PG8_WAIT_L
#undef PG8_BAR
#undef PG8_SCHED
}

template <class T> __device__ __forceinline__ T ldu(const void* ubase, unsigned voff) { return *(const T*)((const char*)ubase + voff); }
template <class T> __device__ __forceinline__ void stu(void* ubase, unsigned voff, T v) { *(T*)((char*)ubase + voff) = v; }
template <class T> __device__ __forceinline__ void stu_nt(void* ubase, unsigned voff, T v) { __builtin_nontemporal_store(v, (T*)((char*)ubase + voff)); }
__device__ __forceinline__ f32x4 tof(f32x4 a) { return a; }
__device__ __forceinline__ f32x4 tof(i32x4 a) { return __builtin_convertvector(a, f32x4); }
struct EpiProj {
    static constexpr int BPERM = 2;
    bf16_t* P; const float* gate_b; const int* pos; const float* sa; const float* sw;
    template <class AccV> __device__ __forceinline__ bool operator()(AccV (&acc)[2][2][4][2], const Unit& u, int wr, int wc, int fr, int fq) const {
        const int rowu = u.pm * BM + wr * 64;
        const int dlu = (wc & 1) * 32;
        const int cbu = u.pn * BM + (wc >> 1) * 128 + dlu;
        const unsigned vP = (unsigned)(fr * PP + 8 * fq) * 2u;
        const int pn = u.pn;
        f32x4 sv[2][2]; float sr[2][4];
#pragma unroll
        for (int bj = 0; bj < 2; ++bj)
#pragma unroll
            for (int n = 0; n < 2; ++n) sv[bj][n] = sw ? ldu<f32x4>(sw + cbu + bj * 64 + 4 * n, (unsigned)(8 * fq) * 4u) : (f32x4){1.f, 1.f, 1.f, 1.f};
#pragma unroll
        for (int ai = 0; ai < 2; ++ai)
#pragma unroll
            for (int m = 0; m < 4; ++m) sr[ai][m] = sa ? ldu<float>(sa + rowu + ai * HALF + m * 16, (unsigned)fr * 4u) : 1.f;
        if (pn >= 16 && pn < 32) {
            float fsc[8];
#pragma unroll
            for (int q = 0; q < 8; ++q) fsc[q] = __builtin_amdgcn_exp2f(-(float)(dlu + 8 * fq + q) * 0.20762050593046014f - 2.651496129472319f);
            float posf[2][4];
#pragma unroll
            for (int ai = 0; ai < 2; ++ai)
#pragma unroll
                for (int m = 0; m < 4; ++m) posf[ai][m] = (float)ldu<int>(pos + rowu + ai * HALF + m * 16, (unsigned)fr * 4u);
#pragma unroll
            for (int ai = 0; ai < 2; ++ai)
#pragma unroll
                for (int m = 0; m < 4; ++m) { const int row = rowu + ai * HALF + m * 16;
                    f32x4 c0, c1, s0, s1;
#pragma unroll
                    for (int q = 0; q < 4; ++q) { const float r0 = __builtin_amdgcn_fractf(posf[ai][m] * fsc[q]), r1 = __builtin_amdgcn_fractf(posf[ai][m] * fsc[4 + q]);
                        c0[q] = __builtin_amdgcn_cosf(r0); s0[q] = __builtin_amdgcn_sinf(r0); c1[q] = __builtin_amdgcn_cosf(r1); s1[q] = __builtin_amdgcn_sinf(r1); }
                    const float rsc = sr[ai][m];
                    const f32x4 x1a = tof(acc[ai][0][m][0]) * rsc * sv[0][0], x1b = tof(acc[ai][0][m][1]) * rsc * sv[0][1], x2a = tof(acc[ai][1][m][0]) * rsc * sv[1][0], x2b = tof(acc[ai][1][m][1]) * rsc * sv[1][1];
                    const f32x4 o1a = x1a * c0 - x2a * s0, o1b = x1b * c1 - x2b * s1, o2a = x2a * c0 + x1a * s0, o2b = x2b * c1 + x1b * s1;
                    bf16_t* rp = P + PLO(cbu) + (size_t)row * PP + (cbu & 2047);
                    u32x4 w; w.x = cvt_pk_bf16(o1a[0], o1a[1]); w.y = cvt_pk_bf16(o1a[2], o1a[3]); w.z = cvt_pk_bf16(o1b[0], o1b[1]); w.w = cvt_pk_bf16(o1b[2], o1b[3]);
                    stu<u32x4>(rp, vP, w);
                    w.x = cvt_pk_bf16(o2a[0], o2a[1]); w.y = cvt_pk_bf16(o2a[2], o2a[3]); w.z = cvt_pk_bf16(o2b[0], o2b[1]); w.w = cvt_pk_bf16(o2b[2], o2b[3]);
                    stu<u32x4>(rp + 64, vP, w); }
            return true;
        }
        const int act = (pn >= 80) ? 2 : 0;
        f32x4 bv[2][2];
#pragma unroll
        for (int bj = 0; bj < 2; ++bj)
#pragma unroll
            for (int n = 0; n < 2; ++n) bv[bj][n] = (act == 2) ? ldu<f32x4>(gate_b + (cbu - COL_GL) + bj * 64 + 4 * n, (unsigned)(8 * fq) * 4u) : (f32x4){0.f, 0.f, 0.f, 0.f};
        if (act == 2) {
#pragma unroll
            for (int bj = 0; bj < 2; ++bj)
#pragma unroll
                for (int n = 0; n < 2; ++n) { sv[bj][n] = sv[bj][n] * -1.4426950408889634f; bv[bj][n] = bv[bj][n] * -1.4426950408889634f; } }
#pragma unroll
        for (int ai = 0; ai < 2; ++ai)
#pragma unroll
            for (int m = 0; m < 4; ++m) { bf16_t* rp = P + PLO(cbu) + (size_t)(rowu + ai * HALF + m * 16) * PP + (cbu & 2047);
#pragma unroll
                for (int bj = 0; bj < 2; ++bj) { f32x4 v0, v1;
#pragma unroll
                    for (int q = 0; q < 4; ++q) { v0[q] = (float)acc[ai][bj][m][0][q] * sr[ai][m] * sv[bj][0][q] + bv[bj][0][q]; v1[q] = (float)acc[ai][bj][m][1][q] * sr[ai][m] * sv[bj][1][q] + bv[bj][1][q]; }
                    if (act == 1) {
#pragma unroll
                        for (int q = 0; q < 4; ++q) { v0[q] = fast_silu(v0[q]); v1[q] = fast_silu(v1[q]); } }
                    else if (act == 2) {
#pragma unroll
                        for (int q = 0; q < 4; ++q) { v0[q] = __builtin_amdgcn_rcpf(1.0f + __builtin_amdgcn_exp2f(v0[q])); v1[q] = __builtin_amdgcn_rcpf(1.0f + __builtin_amdgcn_exp2f(v1[q])); } }
                    u32x4 w; w.x = cvt_pk_bf16(v0[0], v0[1]); w.y = cvt_pk_bf16(v0[2], v0[3]); w.z = cvt_pk_bf16(v1[0], v1[1]); w.w = cvt_pk_bf16(v1[2], v1[3]);
                    stu<u32x4>(rp + bj * 64, vP, w); } }
        return true;
    }
};
struct EpiMerge {
    static constexpr int BPERM = 1;
    bf16_t* MG; const bf16_t* P;
    __device__ __forceinline__ bool operator()(f32x4 (&acc)[2][2][4][2], const Unit& u, int wr, int wc, int fr, int fq) const {
        const int rowu = u.pm * BM + wr * 64, colu = u.pn * BM + wc * 32, j = u.j;
        const unsigned vP = (unsigned)(fr * PP + 8 * fq) * 2u, vM = (unsigned)(fr * DM + 8 * fq) * 2u;
#pragma unroll
        for (int ai = 0; ai < 2; ++ai) {
            u32x4 gw[4][2], nw[4][2];
#pragma unroll
            for (int m = 0; m < 4; ++m) { const bf16_t* gp = P + PLO(COL_GL + j * DM + colu) + (size_t)(rowu + ai * HALF + m * 16) * PP + (colu & 2047);
#pragma unroll
                for (int bj = 0; bj < 2; ++bj) { gw[m][bj] = ldu<u32x4>(gp + bj * HALF, vP); if (j < 2) nw[m][bj] = ldu<u32x4>(gp + 2 * PLANE + bj * HALF, vP); } }
#pragma unroll
            for (int m = 0; m < 4; ++m) { const int row = rowu + ai * HALF + m * 16;
#pragma unroll
                for (int bj = 0; bj < 2; ++bj) {
                    float gj[8]; unpack8(gw[m][bj], gj);
                    if (j < 2) { float gn[8]; unpack8(nw[m][bj], gn);
#pragma unroll
                        for (int q = 0; q < 8; ++q) gj[q] = gj[q] * __builtin_amdgcn_rcpf(fmaxf(gn[q], 1e-30f)); }
#pragma unroll
                    for (int q = 0; q < 4; ++q) { acc[ai][bj][m][0][q] *= gj[q]; acc[ai][bj][m][1][q] *= gj[4 + q]; }
                    if (j == 2) { const f32x4 v0 = acc[ai][bj][m][0], v1 = acc[ai][bj][m][1];
                        u32x4 w; w.x = cvt_pk_bf16(v0[0], v0[1]); w.y = cvt_pk_bf16(v0[2], v0[3]); w.z = cvt_pk_bf16(v1[0], v1[1]); w.w = cvt_pk_bf16(v1[2], v1[3]);
                        stu<u32x4>(MG + (size_t)row * DM + colu + bj * HALF, vM, w); } } }
            asm volatile("" ::: "memory"); }
        return j == 2;
    }
};
template <bool F32IN> struct EpiOut {
    static constexpr int BPERM = 1;
    const void* XI; bf16_t* XO;
    __device__ __forceinline__ bool operator()(f32x4 (&acc)[2][2][4][2], const Unit& u, int wr, int wc, int fr, int fq) const {
        const int rowu = u.pm * BM + wr * 64, colu = u.pn * BM + wc * 32;
        const unsigned vI = (unsigned)(fr * DM + 8 * fq) * (F32IN ? 4u : 2u), vO = (unsigned)(fr * DM + 8 * fq) * 2u;
#pragma unroll
        for (int ai = 0; ai < 2; ++ai) {
            f32x4 xa[4][2], xb[4][2]; u32x4 xh[4][2];
#pragma unroll
            for (int m = 0; m < 4; ++m)
#pragma unroll
                for (int bj = 0; bj < 2; ++bj) { const size_t o = (size_t)(rowu + ai * HALF + m * 16) * DM + colu + bj * HALF;
                    if constexpr (F32IN) { xa[m][bj] = ldu<f32x4>((const float*)XI + o, vI); xb[m][bj] = ldu<f32x4>((const float*)XI + o + 4, vI); }
                    else xh[m][bj] = ldu<u32x4>((const bf16_t*)XI + o, vI); }
#pragma unroll
            for (int m = 0; m < 4; ++m)
#pragma unroll
                for (int bj = 0; bj < 2; ++bj) { const size_t o = (size_t)(rowu + ai * HALF + m * 16) * DM + colu + bj * HALF;
                    f32x4 r0, r1;
                    if constexpr (F32IN) { r0 = xa[m][bj]; r1 = xb[m][bj]; }
                    else { const u32x4 h = xh[m][bj]; r0 = (f32x4){bf_lo(h.x), bf_hi(h.x), bf_lo(h.y), bf_hi(h.y)}; r1 = (f32x4){bf_lo(h.z), bf_hi(h.z), bf_lo(h.w), bf_hi(h.w)}; }
                    r0 = r0 + acc[ai][bj][m][0]; r1 = r1 + acc[ai][bj][m][1];
                    u32x4 w; w.x = cvt_pk_bf16(r0[0], r0[1]); w.y = cvt_pk_bf16(r0[2], r0[3]); w.z = cvt_pk_bf16(r1[0], r1[1]); w.w = cvt_pk_bf16(r1[2], r1[3]);
                    stu<u32x4>(XO + o, vO, w); }
            asm volatile("" ::: "memory"); }
        return true;
    }
};
}

namespace att {
constexpr float SCALE = 0.08838834764831845f;
constexpr int NW = 8, QBLK = 32, KVBLK = 64, QB = NW * QBLK, D = 128;
constexpr int SHM_V = KVBLK * D * 2, SHM_K = KVBLK * D * 2;
constexpr float THR = 8.f;
constexpr int PQ = PP, PKV = PP, PO = DM;
constexpr int WIN = SEQ;
#define KSWZ(row, colB) ((row) * 256 + ((colB) ^ (((row) & 7) << 4)))
#define SBAR() __builtin_amdgcn_sched_barrier(0)
__device__ __forceinline__ int v_st(int k, int c) { const int kk = (k & ~0xC) | ((k & 4) << 1) | ((k & 8) >> 1); return ((kk >> 3) * 4 + (c >> 5)) * 512 + ((kk & 7) * 32 + (c & 31)) * 2; }
__device__ __forceinline__ int v_rd_base(int lane) { return ((lane & 3) << 3) | (((lane >> 2) & 3) << 6) | (((lane >> 4) & 1) << 5) | (((lane >> 5) & 1) << 8); }
constexpr int v_rd_off(int d0, int ks, int half) { return d0 * 512 + ks * 4096 + half * 2048; }
__device__ __forceinline__ int crow(int r, int hi) { return (r & 3) + 8 * (r >> 2) + 4 * hi; }
__device__ __forceinline__ unsigned cvtpk(float lo, float hi) { unsigned r; asm volatile("v_cvt_pk_bf16_f32 %0, %1, %2" : "=v"(r) : "v"(lo), "v"(hi)); return r; }
__device__ __forceinline__ bf16x8 load8(const bf16_t* p) { return *reinterpret_cast<const bf16x8*>(p); }
__device__ __forceinline__ void mask_tile(f32x16& p0, f32x16& p1, int dq, unsigned W) {
    const float NEG = -__builtin_inff();
#pragma unroll
    for (int r = 0; r < 16; ++r) {
        const int c = (r & 3) + 8 * (r >> 2);
        if ((unsigned)(dq - c) >= W) p0[r] = NEG;
        if ((unsigned)(dq - c - 32) >= W) p1[r] = NEG;
    }
}
__device__ __forceinline__ void partialSM(f32x16& p0, f32x16& p1, float& m_reg, float& mn, float& alpha) {
    float pmax = p0[0]; for (int r = 1; r < 16; ++r) pmax = fmaxf(pmax, p0[r]); for (int r = 0; r < 16; ++r) pmax = fmaxf(pmax, p1[r]);
    { auto rr = __builtin_amdgcn_permlane32_swap(__float_as_uint(pmax), __float_as_uint(pmax), false, false);
      pmax = fmaxf(__uint_as_float(rr[0]), __uint_as_float(rr[1])); }
    constexpr float C2 = 1.4426950408889634f * SCALE;
    if (__builtin_expect(__all((pmax - m_reg) * SCALE <= THR), 1)) { mn = m_reg; alpha = 1.f; }
    else { mn = fmaxf(m_reg, pmax); alpha = __builtin_amdgcn_exp2f((m_reg - mn) * C2); m_reg = mn; }
    const float mnL = -mn * C2;
    for (int r = 0; r < 16; ++r) p0[r] = fmaf(p0[r], C2, mnL); for (int r = 0; r < 16; ++r) p1[r] = fmaf(p1[r], C2, mnL);
    for (int r = 0; r < 16; ++r) p0[r] = __builtin_amdgcn_exp2f(p0[r]);
}
__device__ __forceinline__ void finishSM(f32x16& p0, f32x16& p1, float alpha, float& l_reg, bf16x8& pa0, bf16x8& pa1, bf16x8& pa2, bf16x8& pa3) {
    for (int r = 0; r < 16; ++r) p1[r] = __builtin_amdgcn_exp2f(p1[r]);
    float ps = 0; for (int r = 0; r < 16; ++r) ps += p0[r]; for (int r = 0; r < 16; ++r) ps += p1[r];
    { auto rr = __builtin_amdgcn_permlane32_swap(__float_as_uint(ps), __float_as_uint(ps), false, false);
      ps = __uint_as_float(rr[0]) + __uint_as_float(rr[1]); }
    l_reg = l_reg * alpha + ps;
#define PK4(P, B_, OUT) do { unsigned a0 = cvtpk(P[B_+0], P[B_+1]), a1 = cvtpk(P[B_+2], P[B_+3]);                          \
        unsigned b0 = cvtpk(P[B_+4], P[B_+5]), b1 = cvtpk(P[B_+6], P[B_+7]);                                             \
        auto r0 = __builtin_amdgcn_permlane32_swap(a0, b0, false, false); auto r1 = __builtin_amdgcn_permlane32_swap(a1, b1, false, false); \
        u32x4 w = {r0[0], r1[0], r0[1], r1[1]}; OUT = *reinterpret_cast<bf16x8*>(&w); } while (0)
    PK4(p0, 0, pa0); PK4(p0, 8, pa1); PK4(p1, 0, pa2); PK4(p1, 8, pa3);
#undef PK4
}
__device__ __forceinline__ bf16x8 ldg8(const bf16_t* ubase, unsigned boff) { return *reinterpret_cast<const bf16x8*>((const char*)ubase + boff); }
constexpr int LDS2_V = 0, LDS2_K = 4 * SHM_V, LDS2_WS = 4 * SHM_V + 2 * SHM_K, LDS2_BYTES = LDS2_WS + NW * 64 * 4;
template <int VBASE>
__device__ __forceinline__ void pv_both(f32x16* o, int vb0, bf16x8 pa0, bf16x8 pa1, bf16x8 pa2, bf16x8 pa3) {
#define TRRD(dst, off) asm volatile("ds_read_b64_tr_b16 %0, %1 offset:%2" : "=&v"(dst) : "v"(vb0), "i"(off) : "memory")
#define RD8(S, g) do { constexpr int b_ = VBASE + ((g) >> 2) * SHM_V + ((g) & 3) * 512; \
        TRRD(S##l0, b_); TRRD(S##h0, b_ + 2048); TRRD(S##l1, b_ + 4096); TRRD(S##h1, b_ + 6144); TRRD(S##l2, b_ + 8192); TRRD(S##h2, b_ + 10240); TRRD(S##l3, b_ + 12288); TRRD(S##h3, b_ + 14336); } while (0)
#define MM4(S, g) do { \
        o[g] = __builtin_amdgcn_mfma_f32_32x32x16_bf16(pa0, (bf16x8){S##l0[0], S##l0[1], S##l0[2], S##l0[3], S##h0[0], S##h0[1], S##h0[2], S##h0[3]}, o[g], 0, 0, 0);   \
        o[g] = __builtin_amdgcn_mfma_f32_32x32x16_bf16(pa1, (bf16x8){S##l1[0], S##l1[1], S##l1[2], S##l1[3], S##h1[0], S##h1[1], S##h1[2], S##h1[3]}, o[g], 0, 0, 0);   \
        o[g] = __builtin_amdgcn_mfma_f32_32x32x16_bf16(pa2, (bf16x8){S##l2[0], S##l2[1], S##l2[2], S##l2[3], S##h2[0], S##h2[1], S##h2[2], S##h2[3]}, o[g], 0, 0, 0);   \
        o[g] = __builtin_amdgcn_mfma_f32_32x32x16_bf16(pa3, (bf16x8){S##l3[0], S##l3[1], S##l3[2], S##l3[3], S##h3[0], S##h3[1], S##h3[2], S##h3[3]}, o[g], 0, 0, 0); } while (0)
#define STEP_G(CUR, NXT, g) do { RD8(NXT, (g) + 1); asm volatile("s_waitcnt lgkmcnt(8)" ::: "memory"); SBAR(); MM4(CUR, g); } while (0)
    s16x4 Al0, Al1, Al2, Al3, Ah0, Ah1, Ah2, Ah3, Bl0, Bl1, Bl2, Bl3, Bh0, Bh1, Bh2, Bh3;
    RD8(A, 0);
    STEP_G(A, B, 0); STEP_G(B, A, 1); STEP_G(A, B, 2); STEP_G(B, A, 3); STEP_G(A, B, 4); STEP_G(B, A, 5); STEP_G(A, B, 6);
    asm volatile("s_waitcnt lgkmcnt(0)" ::: "memory"); SBAR(); MM4(B, 7);
#undef STEP_G
#undef MM4
#undef RD8
#undef TRRD
}
template <int KB>
__device__ __forceinline__ void qkt2(f32x16& p0, f32x16& p1, int ka0, int ka1, int ka2, int ka3, const bf16x8* qr) {
#define KRD(dst, a, off) asm volatile("ds_read_b128 %0, %1 offset:%2" : "=&v"(dst) : "v"(a), "i"(off) : "memory")
#define RDK(S, a, off) do { KRD(S##0, a, KB * SHM_K + (off)); KRD(S##1, a, KB * SHM_K + (off) + 8192); } while (0)
#define WK(n) do { asm volatile("s_waitcnt lgkmcnt(" #n ")" ::: "memory"); SBAR(); } while (0)
#define MMK(S, d) do { p0 = __builtin_amdgcn_mfma_f32_32x32x16_bf16(S##0, qr[d], p0, 0, 0, 0); p1 = __builtin_amdgcn_mfma_f32_32x32x16_bf16(S##1, qr[d], p1, 0, 0, 0); } while (0)
    bf16x8 A0, A1, B0, B1;
    p0 = f32x16{}; p1 = f32x16{};
    RDK(A, ka0, 0); RDK(B, ka1, 0);
    WK(2); MMK(A, 0); RDK(A, ka2, 0);
    WK(2); MMK(B, 1); RDK(B, ka3, 0);
    WK(2); MMK(A, 2); RDK(A, ka0, 128);
    WK(2); MMK(B, 3); RDK(B, ka1, 128);
    WK(2); MMK(A, 4); RDK(A, ka2, 128);
    WK(2); MMK(B, 5); RDK(B, ka3, 128);
    WK(2); MMK(A, 6);
    WK(0); MMK(B, 7);
#undef MMK
#undef WK
#undef RDK
#undef KRD
}
struct BlockRef2 { const bf16_t* Q; const bf16_t* K; const bf16_t* V; bf16_t* O; int P0; };
__device__ __forceinline__ void causal_block2(const BlockRef2& cur, char* lds) {
    const int wid = __builtin_amdgcn_readfirstlane(threadIdx.x >> 6), lane = fresh_lane(), r32 = lane & 31, hi = lane >> 5;
    constexpr int W = WIN;
    const int NT = cur.P0 / KVBLK + 4;
    const int qlo = cur.P0 + wid * QBLK, qm = qlo + r32 - 4 * hi;
    char* V_lds = lds + LDS2_V; char* K_lds = lds + LDS2_K;
    float* ws = (float*)(lds + LDS2_WS) + wid * 64; float* li_l = ws, * al_l = ws + 32;
    const int vb0 = (int)(uintptr_t)V_lds + v_rd_base(lane);
    const int kab = (int)(uintptr_t)K_lds, ka0 = kab + KSWZ(r32, (0 * 16 + hi * 8) * 2), ka1 = kab + KSWZ(r32, (1 * 16 + hi * 8) * 2), ka2 = kab + KSWZ(r32, (2 * 16 + hi * 8) * 2), ka3 = kab + KSWZ(r32, (3 * 16 + hi * 8) * 2);
    unsigned ksrc[2], vsrc[2];
#pragma unroll
    for (int i = 0; i < 2; ++i) { const int o = i * 8192 + wid * 1024 + lane * 16;
        { const int row = o >> 8, p = (o >> 4) & 15, c = p ^ (row & 7); ksrc[i] = (unsigned)(row * PKV + c * 8) * 2u; }
        { const int q = o >> 4, sub = q >> 5, w4 = q & 31, kk = (sub >> 2) * 8 + (w4 >> 2), c = (sub & 3) * 32 + (w4 & 3) * 8, key = (kk & ~0xC) | ((kk & 4) << 1) | ((kk & 8) >> 1);
          vsrc[i] = (unsigned)(key * PKV + c) * 2u; } }
    const unsigned ldsw = (unsigned)wid * 1024u;
#define DMA16(gp, ldsoff) __builtin_amdgcn_global_load_lds((const unsigned*)(gp), (LAS unsigned*)((LAS char*)lds + (ldsoff)), 16, 0, 0)
#define LOAD_KV(k0, bf) do { const char* kk_ = (const char*)(cur.K + (size_t)(k0) * PKV); const char* vk_ = (const char*)(cur.V + (size_t)(k0) * PKV);            \
        _Pragma("unroll") for (int i_ = 0; i_ < 2; ++i_) { DMA16(kk_ + ksrc[i_], LDS2_K + (bf) * SHM_K + ldsw + i_ * 8192);                                          \
            DMA16(vk_ + vsrc[i_], LDS2_V + ((bf) * 2 + 0) * SHM_V + ldsw + i_ * 8192); DMA16(vk_ + 256 + vsrc[i_], LDS2_V + ((bf) * 2 + 1) * SHM_V + ldsw + i_ * 8192); } } while (0)
    bf16x8 qr[8];
    { const bf16_t* qb = cur.Q + (size_t)(wid * QBLK) * PQ; const unsigned qoff = (unsigned)(r32 * PQ + hi * 8) * 2u;
#pragma unroll
      for (int d0 = 0; d0 < 8; ++d0) qr[d0] = ldg8(qb, qoff + d0 * 32); }
    LOAD_KV(0, 0);
    asm volatile("s_waitcnt vmcnt(0)" ::: "memory"); __builtin_amdgcn_s_barrier(); asm volatile("" ::: "memory");
    float m_reg = -1e30f, l_reg = 0; f32x16 o[8] = {};
#define STEP2(t, CB) do { f32x16 p0, p1; float mn, al; bf16x8 pa0, pa1, pa2, pa3;                                                               \
        if ((t) + 1 < NT) { LOAD_KV(((t) + 1) * KVBLK, (CB) ^ 1); } SBAR();                                                                    \
        qkt2<CB>(p0, p1, ka0, ka1, ka2, ka3, qr);                                                                                                   \
        { const int kb_ = (t) * KVBLK; if (kb_ + KVBLK - 1 > qlo) mask_tile(p0, p1, qm - kb_, (unsigned)W); }                                     \
        partialSM(p0, p1, m_reg, mn, al);                                                                                                       \
        if (__any(al < 1.f)) { if (hi == 0) al_l[r32] = al; asm volatile("s_waitcnt lgkmcnt(0)" ::: "memory");                                    \
            for (int d_ = 0; d_ < 8; ++d_) for (int r = 0; r < 16; ++r) o[d_][r] *= al_l[crow(r, hi)]; }                                          \
        finishSM(p0, p1, al, l_reg, pa0, pa1, pa2, pa3); SBAR();                                                                                \
        pv_both<(CB) * 2 * SHM_V>(o, vb0, pa0, pa1, pa2, pa3);             \
        asm volatile("s_waitcnt vmcnt(0) lgkmcnt(0)" ::: "memory"); __builtin_amdgcn_s_barrier(); asm volatile("" ::: "memory"); } while (0)
    for (int t = 0; t < NT; t += 2) { STEP2(t, 0); STEP2(t + 1, 1); }
#undef STEP2
#undef LOAD_KV
#undef DMA16
    const int lz = fresh_lane(), r32z = lz & 31, hiz = lz >> 5;
    if (hiz == 0) li_l[r32z] = l_reg; asm volatile("s_waitcnt lgkmcnt(0)" ::: "memory");
    float rli[16];
#pragma unroll
    for (int r = 0; r < 16; ++r) rli[r] = __builtin_amdgcn_rcpf(li_l[crow(r, hiz)]);
    unsigned zhi = 0u; asm volatile("" : "+v"(zhi));
    char* lanep = (char*)(cur.O + (size_t)(wid * QBLK) * PO) + (((size_t)zhi << 32) | (size_t)((unsigned)(hiz * 4 * PO + r32z) * 2u));
#pragma unroll
    for (int r = 0; r < 16; ++r) { const int rb = (r & 3) + 8 * (r >> 2);
#pragma unroll
        for (int d0 = 0; d0 < 8; ++d0) { const float v = o[d0][r] * rli[r];
            const float vn = __shfl_xor(v, 1);
            if ((r32z & 1) == 0) *(unsigned*)(lanep + (size_t)rb * PO * 2 + d0 * 64) = cvtpk(v, vn); } }
    asm volatile("s_waitcnt lgkmcnt(0)" ::: "memory"); __builtin_amdgcn_s_barrier(); asm volatile("" ::: "memory");
}
}

constexpr size_t MiB = (size_t)1 << 20;
constexpr size_t WS_CTL = 0, CTL_ZERO_BYTES = 1 * MiB;
constexpr size_t WS_C8 = 9 * MiB;
constexpr size_t WS_CARA = 10 * MiB, WS_CARH = 12 * MiB, WS_CIN = 14 * MiB;
constexpr size_t WS_WG = 16 * MiB;
constexpr size_t WS_WO = 32 * MiB;
constexpr size_t WS_WB = 160 * MiB;
constexpr size_t WS_WIN = 352 * MiB;
constexpr size_t WS_H = 1376 * MiB;
constexpr size_t WS_PROJ = 1504 * MiB;
constexpr size_t WS_HL = 2720 * MiB;
constexpr size_t WS_OB = 2848 * MiB;
constexpr size_t WS_Y = 2976 * MiB;
constexpr size_t WS_MG = 3168 * MiB;
constexpr size_t WS_XB = 3296 * MiB;
constexpr size_t WS_XB1 = 3552 * MiB;
constexpr size_t WS_WQ = 3808 * MiB;
constexpr size_t WS_HQ = 4320 * MiB;
constexpr size_t WS_END = 4384 * MiB;
constexpr size_t WS_SW = 9 * MiB + 64 * 1024;
constexpr size_t WS_SA = 9 * MiB + 640 * 1024;
constexpr int CW_BAR = 4096;
constexpr int CW_DBG = 65536;

constexpr int RING_OFF = 0, RING_BYTES = 131072;
constexpr int LDS_BYTES = 147456;
constexpr int LDSCTL_OFF = LDS_BYTES - 1024, MISC_OFF = LDSCTL_OFF + 320;
constexpr int NWAVES = 8;

#define XB_TMO      128
#define XB_XCNT(j)  (256  + 64 * (j))
#define XB_XSUB(j)  (1280 + 64 * (j))
#define XB_XGEN(j)  (2304 + 64 * (j))
#define XB_TOP      3328
#define XB_TOPGEN   3392
#define XCD_BAR_WORDS 3456
#define XB_SPIN_CAP (1u << 18)
__device__ __forceinline__ unsigned xb_ld(unsigned* p)              { return __hip_atomic_load(p, __ATOMIC_RELAXED, __HIP_MEMORY_SCOPE_AGENT); }
__device__ __forceinline__ unsigned xb_add(unsigned* p, unsigned v) { return __hip_atomic_fetch_add(p, v, __ATOMIC_RELAXED, __HIP_MEMORY_SCOPE_AGENT); }
__device__ __forceinline__ unsigned xb_xcc_id() { return (unsigned)__builtin_amdgcn_s_getreg((3 << 11) | 20) & 0xFu; }
#define XB_SPIN(cond, bar) do { unsigned _sp = 0; while (cond) { __builtin_amdgcn_s_sleep(1); \
    if ((++_sp & 255u) == 0u) { if (xb_ld(&(bar)[XB_TMO])) break; if (_sp > XB_SPIN_CAP) { atomicAdd(&(bar)[XB_TMO], 1u); break; } } } } while (0)
struct XcdBarrier { unsigned* bar; unsigned x; volatile LAS unsigned* st; };
__device__ __forceinline__ XcdBarrier xcd_barrier_post(unsigned* bar, volatile LAS unsigned* st) {
    XcdBarrier b; b.bar = bar; b.x = xb_xcc_id(); b.st = st;
    if (threadIdx.x == 0) (void)xb_add(&bar[XB_XCNT(b.x)], 1u);
    return b;
}
__device__ __forceinline__ void xcd_barrier_complete(unsigned* bar, unsigned x, unsigned& nloc, unsigned& nx) {
    const unsigned G = gridDim.x * gridDim.y * gridDim.z;
    unsigned sum, cnt, mine, sp = 0u;
    for (;;) {
        sum = 0u; cnt = 0u; mine = 0u;
#pragma unroll
        for (unsigned j = 0; j < 16; ++j) { const unsigned c = xb_ld(&bar[XB_XCNT(j)]); sum += c; cnt += (c > 0u) ? 1u : 0u; mine = (j == x) ? c : mine; }
        if (sum == G) break;
        __builtin_amdgcn_s_sleep(1);
        if ((++sp & 255u) == 0u) { if (xb_ld(&bar[XB_TMO])) break; if (sp > XB_SPIN_CAP) { atomicAdd(&bar[XB_TMO], 1u); break; } }
    }
    nloc = mine > 0u ? mine : 1u; nx = cnt > 0u ? cnt : 1u;
}
__device__ __forceinline__ void xcd_barrier(const XcdBarrier& b) {
    asm volatile("s_waitcnt vmcnt(0)" ::: "memory");
    __syncthreads();
    if (threadIdx.x == 0) {
        unsigned* bar = b.bar;
        __builtin_amdgcn_s_waitcnt(0);
        unsigned nloc = b.st[0], nx = b.st[1];
        if (nloc == 0u) { xcd_barrier_complete(bar, b.x, nloc, nx); b.st[0] = nloc; b.st[1] = nx; }
        const unsigned old = xb_add(&bar[XB_XSUB(b.x)], 1u);
        const unsigned gen = old / nloc;
        if (old + 1u == (gen + 1u) * nloc) {
            __builtin_amdgcn_fence(__ATOMIC_RELEASE, "agent");
            asm volatile("s_waitcnt vmcnt(0)" ::: "memory");
            const unsigned og = xb_add(&bar[XB_TOP], 1u);
            const unsigned tg = og / nx;
            if (og + 1u == (tg + 1u) * nx) xb_add(&bar[XB_TOPGEN], 1u);
            else XB_SPIN(xb_ld(&bar[XB_TOPGEN]) == tg, bar);
            __builtin_amdgcn_fence(__ATOMIC_ACQUIRE, "agent");
            xb_add(&bar[XB_XGEN(b.x)], 1u);
            asm volatile("s_waitcnt vmcnt(0)" ::: "memory");
        } else {
            XB_SPIN(xb_ld(&bar[XB_XGEN(b.x)]) == gen, bar);
            __builtin_amdgcn_fence(__ATOMIC_ACQUIRE, "agent");
            asm volatile("s_waitcnt vmcnt(0)" ::: "memory");
        }
    }
    __syncthreads();
}

#define LDS_WAIT() asm volatile("s_waitcnt lgkmcnt(0)" ::: "memory")
struct Frame {
    LAS unsigned char* lds;
    int wave, vcu, G;
    int gw, NGW, NGT;
    unsigned char* ws;
    const void* const* in;
    float* out;
    __device__ __forceinline__ const float* fin(int k) const { int kk = k; asm volatile("" : "+s"(kk)); return (const float*)in[kk]; }
    __device__ __forceinline__ int gwo() const { int g = gw; asm volatile("" : "+s"(g)); return g; }
    __device__ __forceinline__ unsigned char* wsp(size_t off) const { size_t z = 0; asm volatile("" : "+s"(z)); return ws + (z + off); }
};
enum { I_X = 0, I_POS, I_NORM_W, I_W_IN, I_GATE_B, I_CONV_A_W, I_CONV_A_B, I_W_RG, I_B_RG, I_W_IG, I_B_IG, I_LAMBDA, I_LQ1, I_LK1, I_LQ2, I_LK2, I_SUBLN, I_CONV_C_W, I_W_BRANCH, I_W_OUT, I_FINAL_W };

__device__ __forceinline__ void transpose_item(const float* src, int N, int k0, int n0, bf16_t* dst, int dpitch, LAS float* scr, int lane) {
#pragma unroll 8
    for (int i = 0; i < 32; ++i) { const int kk = 2 * i + (lane >> 5); scr[kk * 33 + (lane & 31)] = src[(size_t)(k0 + kk) * N + n0 + (lane & 31)]; }
    LDS_WAIT(); asm volatile("" ::: "memory");
    const int c = lane & 7;
#pragma unroll
    for (int j = 0; j < 4; ++j) { const int n = (lane >> 3) + 8 * j; const LAS float* s = scr + (8 * c) * 33 + n;
        u32x4 o; o.x = cvt_pk_bf16(s[0 * 33], s[1 * 33]); o.y = cvt_pk_bf16(s[2 * 33], s[3 * 33]); o.z = cvt_pk_bf16(s[4 * 33], s[5 * 33]); o.w = cvt_pk_bf16(s[6 * 33], s[7 * 33]);
        *(u32x4*)(dst + (size_t)n * dpitch + 8 * c) = o; }
    LDS_WAIT(); asm volatile("" ::: "memory");
}
__device__ __forceinline__ void p_prologue(Frame& F) {
    const int lane = fresh_lane(), tid = F.wave * 64 + lane, gt = F.gw * 64 + lane; (void)gt; (void)tid;
    LAS float* scr = (LAS float*)(F.lds + RING_OFF + F.wave * 16384);
    constexpr int I_IN = (DM / 64) * (NB_TILES * 8);
    constexpr int I_BR = (BW / 64) * (DM / 32);
    constexpr int I_OUT = (DM / 64) * (DM / 32);
    constexpr int I_G = (256 / 64) * (256 / 32);
    constexpr int T_IN = DEPTH * I_IN, T_BR = DEPTH * 3 * I_BR, T_OUT = DEPTH * I_OUT, T_G = DEPTH * 8 * 2 * I_G;
    constexpr int NITEMS = T_IN + T_BR + T_OUT + T_G;
    bf16_t* WIN = (bf16_t*)F.wsp(WS_WIN); bf16_t* WB = (bf16_t*)F.wsp(WS_WB); bf16_t* WO = (bf16_t*)F.wsp(WS_WO); bf16_t* WG = (bf16_t*)F.wsp(WS_WG);
    for (int it = F.gw; it < NITEMS; it += F.NGW) {
        int r = it;
        if (r < T_IN) { const int l = r / I_IN; r -= l * I_IN; const int nblk = NB_TILES * 8, kb = r / nblk, nb = r % nblk, n0 = b_tile(nb >> 3) * 256 + (nb & 7) * 32;
            transpose_item(F.fin(I_W_IN) + (size_t)l * DM * INC, INC, 64 * kb, n0, WIN + (size_t)l * INC * DM + (size_t)n0 * DM + 64 * kb, DM, scr, lane); continue; }
        r -= T_IN;
        if (r < T_BR) { const int lj = r / I_BR; r -= lj * I_BR; const int l = lj / 3, j = lj - 3 * l; const int nblk = DM / 32, kb = r / nblk, nb = r % nblk;
            transpose_item(F.fin(I_W_BRANCH) + (size_t)lj * BW * DM, DM, 64 * kb, 32 * nb, WB + (size_t)l * DM * YW + (size_t)(32 * nb) * YW + j * BW + 64 * kb, YW, scr, lane); continue; }
        r -= T_BR;
        if (r < T_OUT) { const int l = r / I_OUT; r -= l * I_OUT; const int nblk = DM / 32, kb = r / nblk, nb = r % nblk;
            transpose_item(F.fin(I_W_OUT) + (size_t)l * DM * DM, DM, 64 * kb, 32 * nb, WO + (size_t)l * DM * DM + (size_t)(32 * nb) * DM + 64 * kb, DM, scr, lane); continue; }
        r -= T_OUT;
        { const int lng = r / I_G; r -= lng * I_G; const int gate = lng & 1, ln = lng >> 1, n = ln & 7, l = ln >> 3; const int kb = r / 8, nb = r % 8, n0 = 32 * nb;
            const float* src = (gate ? F.fin(I_W_IG) : F.fin(I_W_RG)) + (size_t)(l * 8 + n) * 65536;
            bf16_t* dst = WG + (size_t)l * 16 * 65536 + (size_t)((n * 2 + (n0 >> 7)) * 256 + gate * 128 + (n0 & 127)) * 256 + 64 * kb;
            transpose_item(src, 256, 64 * kb, n0, dst, 256, scr, lane); }
    }
    float* C8 = (float*)F.wsp(WS_C8); const float* lamp = F.fin(I_LAMBDA);
    for (int idx = gt; idx < DEPTH * BW; idx += F.NGT) { const float lam = lamp[idx]; const float ls = -log1pf(expf(-lam)); C8[idx] = 8.0f * 1.4426950408889634f * ls; }
}

__device__ __forceinline__ float wave_max(float v) {
#pragma unroll
    for (int o = 1; o < 64; o <<= 1) v = fmaxf(v, __shfl_xor(v, o));
    return v;
}
__device__ __forceinline__ unsigned pack_i8x4(float a, float b, float c, float d) {
    const int ia = (int)__builtin_rintf(a), ib = (int)__builtin_rintf(b), ic = (int)__builtin_rintf(c), id = (int)__builtin_rintf(d);
    return ((unsigned)ia & 0xffu) | (((unsigned)ib & 0xffu) << 8) | (((unsigned)ic & 0xffu) << 16) | ((unsigned)id << 24);
}
template <bool F32IN> __device__ __forceinline__ void p_rmsnorm_bf16(Frame& F, const void* X, const float* w, bf16_t* H) {
    const int lane = fresh_lane();
    signed char* HQ = (signed char*)F.wsp(WS_HQ); float* SA = (float*)F.wsp(WS_SA);
    f32x4 wreg[16];
#pragma unroll
    for (int j = 0; j < 16; ++j) wreg[j] = ((const f32x4*)w)[lane + 64 * j];
    for (int row = F.gwo(); row < MTOK; row += F.NGW) {
        f32x4 v[16]; float s = 0.f, mx = 0.f;
        if constexpr (F32IN) { const f32x4* xr = (const f32x4*)((const float*)X + (size_t)row * DM) + lane;
#pragma unroll
            for (int j = 0; j < 16; ++j) v[j] = xr[64 * j]; }
        else { const u32x2* xr = (const u32x2*)((const bf16_t*)X + (size_t)row * DM) + lane;
#pragma unroll
            for (int j = 0; j < 16; ++j) { const u32x2 h = xr[64 * j]; v[j] = (f32x4){bf_lo(h.x), bf_hi(h.x), bf_lo(h.y), bf_hi(h.y)}; } }
#pragma unroll
        for (int j = 0; j < 16; ++j) s += (v[j].x * v[j].x + v[j].y * v[j].y) + (v[j].z * v[j].z + v[j].w * v[j].w);
#pragma unroll
        for (int j = 0; j < 16; ++j) { v[j] = v[j] * wreg[j];
            mx = fmaxf(fmaxf(mx, fmaxf(__builtin_fabsf(v[j].x), __builtin_fabsf(v[j].y))), fmaxf(__builtin_fabsf(v[j].z), __builtin_fabsf(v[j].w))); }
        const float rs = 1.0f / __builtin_sqrtf(wave_sum(s) * (1.0f / DM) + 1e-6f);
        const float amax = wave_max(mx) * rs;
        const float sc = amax > 0.f ? amax * (1.0f / 127.0f) : 1.0f, qi = rs / sc;
        u32x2* o8 = (u32x2*)(H + (size_t)row * DM) + lane;
        unsigned* q4 = (unsigned*)(HQ + (size_t)row * DM) + lane;
#pragma unroll
        for (int j = 0; j < 16; ++j) { u32x2 o; o.x = cvt_pk_bf16(v[j].x * rs, v[j].y * rs); o.y = cvt_pk_bf16(v[j].z * rs, v[j].w * rs); o8[64 * j] = o;
            q4[64 * j] = pack_i8x4(v[j].x * qi, v[j].y * qi, v[j].z * qi, v[j].w * qi); }
        if (lane == 0) SA[row] = sc;
    }
}
__device__ __forceinline__ void p_wquant(Frame& F) {
    const int lane = fresh_lane();
    const bf16_t* WIN = (const bf16_t*)F.wsp(WS_WIN); signed char* WQ = (signed char*)F.wsp(WS_WQ); float* SW = (float*)F.wsp(WS_SW);
    constexpr int NROW = NQ_TILES * 256;
    for (int i0 = F.gwo(); i0 < DEPTH * NROW; i0 += 2 * F.NGW) {
        u32x4 wv[2][8]; size_t rr[2]; bool ok[2];
#pragma unroll
        for (int k = 0; k < 2; ++k) { const int i = i0 + k * F.NGW; ok[k] = i < DEPTH * NROW; const int ii = ok[k] ? i : i0; const int l = ii / NROW, j0 = ii - l * NROW, n = q_tile(j0 >> 8) * 256 + (j0 & 255);
            rr[k] = (size_t)l * INC + n; const u32x4* src = (const u32x4*)(WIN + rr[k] * DM) + lane;
#pragma unroll
            for (int j = 0; j < 8; ++j) wv[k][j] = src[64 * j]; }
#pragma unroll
        for (int k = 0; k < 2; ++k) { float mx = 0.f;
#pragma unroll
            for (int j = 0; j < 8; ++j)
#pragma unroll
                for (int q = 0; q < 4; ++q) mx = fmaxf(mx, fmaxf(__builtin_fabsf(bf_lo(wv[k][j][q])), __builtin_fabsf(bf_hi(wv[k][j][q]))));
            const float amax = wave_max(mx), sc = amax > 0.f ? amax * (1.0f / 127.0f) : 1.0f, qi = 1.0f / sc;
            if (ok[k]) { u32x2* dst = (u32x2*)(WQ + rr[k] * DM) + lane;
#pragma unroll
                for (int j = 0; j < 8; ++j) { u32x2 o; o.x = pack_i8x4(bf_lo(wv[k][j].x) * qi, bf_hi(wv[k][j].x) * qi, bf_lo(wv[k][j].y) * qi, bf_hi(wv[k][j].y) * qi);
                    o.y = pack_i8x4(bf_lo(wv[k][j].z) * qi, bf_hi(wv[k][j].z) * qi, bf_lo(wv[k][j].w) * qi, bf_hi(wv[k][j].w) * qi); dst[64 * j] = o; }
                if (lane == 0) SW[rr[k]] = sc; } }
    }
}
constexpr int WQ_PITCH = 8208;
static_assert(16 * WQ_PITCH + 8 * 16 * 4 <= LDSCTL_OFF, "fused weight quantiser LDS map");
__device__ __forceinline__ void p_wquant_fused(Frame& F) {
    const int lane = fresh_lane(), wv = F.wave, tid = wv * 64 + lane, cp = lane & 7, rq = lane >> 3;
    LAS unsigned char* S = F.lds; LAS float* red = (LAS float*)(F.lds + 16 * WQ_PITCH);
    signed char* WQ = (signed char*)F.wsp(WS_WQ); float* SW = (float*)F.wsp(WS_SW);
    const float* win = F.fin(I_W_IN);
    constexpr int UPL = NQ_TILES * 16, NU = DEPTH * UPL;
    __syncthreads();
    for (int u = blockIdx.x; u < NU; u += F.G) {
        const int l = u / UPL, r0 = u - l * UPL, r = 2 * ((r0 >> 4) * 8 + (r0 & 7)) + ((r0 >> 3) & 1), n0 = q_tile(r >> 4) * 256 + (r & 15) * 16;
        const float* src = win + (size_t)l * DM * INC + n0 + 2 * cp;
        float mx0 = 0.f, mx1 = 0.f;
#pragma unroll 1
        for (int i0 = 0; i0 < 32; i0 += 8) {
            f32x2 a[8], b[8];
#pragma unroll
            for (int i = 0; i < 8; ++i) { const int k = (wv + 8 * (i0 + i)) * 16 + 2 * rq; a[i] = *(const f32x2*)(src + (size_t)k * INC); b[i] = *(const f32x2*)(src + (size_t)(k + 1) * INC); }
#pragma unroll
            for (int i = 0; i < 8; ++i) { const int k = (wv + 8 * (i0 + i)) * 16 + 2 * rq;
                const unsigned w0 = cvt_pk_bf16(a[i].x, b[i].x), w1 = cvt_pk_bf16(a[i].y, b[i].y);
                mx0 = fmaxf(mx0, fmaxf(__builtin_fabsf(bf_lo(w0)), __builtin_fabsf(bf_hi(w0)))); mx1 = fmaxf(mx1, fmaxf(__builtin_fabsf(bf_lo(w1)), __builtin_fabsf(bf_hi(w1))));
                *(LAS unsigned*)(S + (2 * cp) * WQ_PITCH + k * 2) = w0; *(LAS unsigned*)(S + (2 * cp + 1) * WQ_PITCH + k * 2) = w1; }
        }
#pragma unroll
        for (int o = 8; o < 64; o <<= 1) { mx0 = fmaxf(mx0, __shfl_xor(mx0, o)); mx1 = fmaxf(mx1, __shfl_xor(mx1, o)); }
        if (rq == 0) { red[wv * 16 + 2 * cp] = mx0; red[wv * 16 + 2 * cp + 1] = mx1; }
        __syncthreads();
        { const int n = tid >> 5, j = tid & 31;
          float amax = 0.f;
#pragma unroll
          for (int w = 0; w < 8; ++w) amax = fmaxf(amax, red[w * 16 + n]);
          const float sc = amax > 0.f ? amax * (1.0f / 127.0f) : 1.0f, qi = 1.0f / sc;
          const size_t row = (size_t)l * INC + n0 + n;
          const LAS unsigned char* sp = S + n * WQ_PITCH + j * 16;
          u32x2* dst = (u32x2*)(WQ + row * DM) + j;
#pragma unroll 4
          for (int m = 0; m < 16; ++m) { const u32x4 v = *(const LAS u32x4*)(sp + m * 512);
              u32x2 o; o.x = pack_i8x4(bf_lo(v.x) * qi, bf_hi(v.x) * qi, bf_lo(v.y) * qi, bf_hi(v.y) * qi); o.y = pack_i8x4(bf_lo(v.z) * qi, bf_hi(v.z) * qi, bf_lo(v.w) * qi, bf_hi(v.w) * qi);
              dst[32 * m] = o; }
          if (j == 0) SW[row] = sc; }
        __syncthreads();
    }
}
__device__ __forceinline__ void p_rmsnorm_f32(Frame& F, const bf16_t* X, const float* w, float* O) {
    const int lane = fresh_lane();
    f32x4 wreg[16];
#pragma unroll
    for (int j = 0; j < 16; ++j) wreg[j] = ((const f32x4*)w)[lane + 64 * j];
    for (int row = F.gwo(); row < MTOK; row += F.NGW) {
        const u32x2* xr = (const u32x2*)(X + (size_t)row * DM) + lane;
        f32x4 v[16]; float s = 0.f;
#pragma unroll
        for (int j = 0; j < 16; ++j) { const u32x2 h = xr[64 * j]; v[j] = (f32x4){bf_lo(h.x), bf_hi(h.x), bf_lo(h.y), bf_hi(h.y)}; s += (v[j].x * v[j].x + v[j].y * v[j].y) + (v[j].z * v[j].z + v[j].w * v[j].w); }
        const float rs = 1.0f / __builtin_sqrtf(wave_sum(s) * (1.0f / DM) + 1e-6f);
        f32x4* o = (f32x4*)(O + (size_t)row * DM) + lane;
#pragma unroll
        for (int j = 0; j < 16; ++j) o[64 * j] = v[j] * rs * wreg[j];
    }
}

constexpr int XT_PITCH = 544;
__device__ __forceinline__ void p_lru(Frame& F, int l) {
    const int lane = fresh_lane(), wv = F.wave, tid = wv * 64 + lane, fr = lane & 15, fq = lane >> 4;
    LAS unsigned char* XT = F.lds + RING_OFF;
    const bf16_t* P = (const bf16_t*)F.wsp(WS_PROJ);
    const bf16_t* WGl = (const bf16_t*)F.wsp(WS_WG) + (size_t)l * 16 * 65536;
    unsigned* HP = (unsigned*)F.wsp(WS_HL);
    float* CARA = (float*)F.wsp(WS_CARA); float* CARH = (float*)F.wsp(WS_CARH);
    const float* caw = F.fin(I_CONV_A_W) + (size_t)l * 4 * BW; const float* cab = F.fin(I_CONV_A_B) + (size_t)l * BW;
    const float* brg = F.fin(I_B_RG) + (size_t)l * BW; const float* big = F.fin(I_B_IG) + (size_t)l * BW; const float* c8 = (const float*)F.wsp(WS_C8) + (size_t)l * BW;
    constexpr int NUNIT = NBATCH * 8 * NCHUNK;
    const int n = blockIdx.x & 7;
    bf16x8 Br[2][8], Bi[2][8]; float vbr[2], vbi[2], vc8[2];
#pragma unroll
    for (int nt = 0; nt < 2; ++nt) { const int d = wv * 32 + nt * 16 + fr, ch = n * 256 + d;
        const bf16_t* wr_ = WGl + (size_t)((n * 2 + (d >> 7)) * 256 + (d & 127)) * 256 + 8 * fq;
#pragma unroll
        for (int ks = 0; ks < 8; ++ks) { Br[nt][ks] = *(const bf16x8*)(wr_ + ks * 32); Bi[nt][ks] = *(const bf16x8*)(wr_ + 128 * 256 + ks * 32); }
        vbr[nt] = brg[ch]; vbi[nt] = big[ch]; vc8[nt] = c8[ch]; }
    const int chg = n * 256 + (tid & 63) * 4;
    float cw[4][4], cbb[4];
#pragma unroll
    for (int j = 0; j < 4; ++j) { const f32x4 x0 = *(const f32x4*)(caw + (size_t)j * BW + chg);
#pragma unroll
        for (int q = 0; q < 4; ++q) cw[j][q] = x0[q]; }
    { const f32x4 x0 = *(const f32x4*)(cab + chg);
#pragma unroll
      for (int q = 0; q < 4; ++q) cbb[q] = x0[q]; }
    for (int rr = blockIdx.x >> 3; rr < NUNIT / 8; rr += F.G >> 3) {
        const int tile = rr & (NCHUNK - 1), b = rr / NCHUNK;
        const int s0 = tile * CHUNK; const size_t tok0 = (size_t)b * SEQ + s0;
        { const int rg = tid >> 6;
          const bf16_t* colp = P + PLO(COL_AX) + (tok0 + (size_t)rg * 16) * PP + chg;
          float xm3[4], xm2[4], xm1[4];
#pragma unroll
          for (int q = 0; q < 4; ++q) { xm3[q] = 0.f; xm2[q] = 0.f; xm1[q] = 0.f; }
          if (s0 + rg * 16 != 0) { const u32x2 h3 = *(const u32x2*)(colp - (size_t)3 * PP), h2 = *(const u32x2*)(colp - (size_t)2 * PP), h1 = *(const u32x2*)(colp - (size_t)1 * PP);
              xm3[0] = bf_lo(h3.x); xm3[1] = bf_hi(h3.x); xm3[2] = bf_lo(h3.y); xm3[3] = bf_hi(h3.y); xm2[0] = bf_lo(h2.x); xm2[1] = bf_hi(h2.x); xm2[2] = bf_lo(h2.y); xm2[3] = bf_hi(h2.y);
              xm1[0] = bf_lo(h1.x); xm1[1] = bf_hi(h1.x); xm1[2] = bf_lo(h1.y); xm1[3] = bf_hi(h1.y); }
#pragma unroll
          for (int hb = 0; hb < 2; ++hb) {
              u32x2 xr[8];
#pragma unroll
              for (int r = 0; r < 8; ++r) xr[r] = *(const u32x2*)(colp + (size_t)(hb * 8 + r) * PP);
#pragma unroll
              for (int r = 0; r < 8; ++r) { const float x0[4] = {bf_lo(xr[r].x), bf_hi(xr[r].x), bf_lo(xr[r].y), bf_hi(xr[r].y)}; float y[4];
#pragma unroll
                  for (int q = 0; q < 4; ++q) { y[q] = cbb[q] + cw[0][q] * xm3[q] + cw[1][q] * xm2[q] + cw[2][q] * xm1[q] + cw[3][q] * x0[q]; xm3[q] = xm2[q]; xm2[q] = xm1[q]; xm1[q] = x0[q]; }
                  u32x2 o; o.x = cvt_pk_bf16(y[0], y[1]); o.y = cvt_pk_bf16(y[2], y[3]);
                  *(LAS u32x2*)(XT + (rg * 16 + hb * 8 + r) * XT_PITCH + (tid & 63) * 8) = o; } }
        }
        __syncthreads();
        {
            float Ac[2] = {1.f, 1.f}, Hc[2] = {0.f, 0.f};
#pragma unroll 1
            for (int rt = 0; rt < CHUNK / 16; ++rt) {
                const LAS unsigned char* ap = XT + (rt * 16 + fr) * XT_PITCH + fq * 16;
                f32x4 cr[2], ci[2];
#pragma unroll
                for (int nt = 0; nt < 2; ++nt) { cr[nt] = (f32x4){0.f, 0.f, 0.f, 0.f}; ci[nt] = (f32x4){0.f, 0.f, 0.f, 0.f}; }
#pragma unroll
                for (int kh = 0; kh < 2; ++kh) { bf16x8 af[4];
#pragma unroll
                    for (int ks = 0; ks < 4; ++ks) af[ks] = *(const LAS bf16x8*)(ap + (kh * 4 + ks) * 64);
#pragma unroll
                    for (int ks = 0; ks < 4; ++ks)
#pragma unroll
                        for (int nt = 0; nt < 2; ++nt) { cr[nt] = __builtin_amdgcn_mfma_f32_16x16x32_bf16(af[ks], Br[nt][kh * 4 + ks], cr[nt], 0, 0, 0); ci[nt] = __builtin_amdgcn_mfma_f32_16x16x32_bf16(af[ks], Bi[nt][kh * 4 + ks], ci[nt], 0, 0, 0); } }
#pragma unroll
                for (int nt = 0; nt < 2; ++nt) {
                    const int d = wv * 32 + nt * 16 + fr, ch = n * 256 + d;
                    const LAS unsigned char* xp = XT + (rt * 16 + 4 * fq) * XT_PITCH + d * 2;
                    float Pl[4], Hl[4];
#pragma unroll
                    for (int jj = 0; jj < 4; ++jj) { const float xc = bf2f(*(const LAS bf16_t*)(xp + jj * XT_PITCH));
                        const float r = fast_sigmoid(cr[nt][jj] + vbr[nt]), ig = fast_sigmoid(ci[nt][jj] + vbi[nt]);
                        const float L2 = r * vc8[nt], av = __builtin_amdgcn_exp2f(L2), uv = xc * ig * __builtin_amdgcn_sqrtf(__builtin_fmaf(-av, av, 1.0f));
                        Pl[jj] = (jj == 0) ? av : Pl[jj - 1] * av; Hl[jj] = (jj == 0) ? uv : av * Hl[jj - 1] + uv; }
                    const float A0 = __shfl(Pl[3], fr), A1 = __shfl(Pl[3], fr + 16), A2 = __shfl(Pl[3], fr + 32), A3 = __shfl(Pl[3], fr + 48);
                    const float H0 = __shfl(Hl[3], fr), H1 = __shfl(Hl[3], fr + 16), H2 = __shfl(Hl[3], fr + 32), H3 = __shfl(Hl[3], fr + 48);
                    const float A01 = A1 * A0, H01 = A1 * H0 + H1, A012 = A2 * A01, H012 = A2 * H01 + H2;
                    const float Ae = fq == 0 ? 1.f : (fq == 1 ? A0 : (fq == 2 ? A01 : A012)), He = fq == 0 ? 0.f : (fq == 1 ? H0 : (fq == 2 ? H01 : H012));
                    const float At = A3 * A012, Ht = A3 * H012 + H3;
                    const float Ap = Ac[nt] * Ae, Hp = Ae * Hc[nt] + He;
                    unsigned* op = HP + (tok0 + (size_t)(rt * 16 + 4 * fq)) * BW + ch;
#pragma unroll
                    for (int jj = 0; jj < 4; ++jj) op[(size_t)jj * BW] = cvt_pk_bf16(Pl[jj] * Hp + Hl[jj], Ap * Pl[jj]);
                    Hc[nt] = At * Hc[nt] + Ht; Ac[nt] = Ac[nt] * At;
                }
            }
#pragma unroll
            for (int nt = 0; nt < 2; ++nt) if (fq == 0) { const int ch = n * 256 + wv * 32 + nt * 16 + fr; const size_t ci_ = (size_t)(b * NCHUNK + tile) * BW + ch; CARA[ci_] = Ac[nt]; CARH[ci_] = Hc[nt]; }
        }
        __syncthreads();
    }
}
__device__ __forceinline__ void p_carry(Frame& F) {
    const int lane = fresh_lane(), tid = F.wave * 64 + lane;
    const float* CARA = (const float*)F.wsp(WS_CARA); const float* CARH = (const float*)F.wsp(WS_CARH); float* CIN = (float*)F.wsp(WS_CIN);
    if (tid < 32) {
        for (int task = blockIdx.x * 32 + tid; task < NBATCH * BW; task += F.G * 32) { const int b = task >> 11, ch = task & (BW - 1);
            float ca[NCHUNK], chh[NCHUNK];
#pragma unroll
            for (int c = 0; c < NCHUNK; ++c) { const size_t idx = (size_t)(b * NCHUNK + c) * BW + ch; ca[c] = CARA[idx]; chh[c] = CARH[idx]; }
            float hin = 0.f;
#pragma unroll
            for (int c = 0; c < NCHUNK; ++c) { const size_t idx = (size_t)(b * NCHUNK + c) * BW + ch; CIN[idx] = hin; hin = ca[c] * hin + chh[c]; } }
    }
}

__device__ __forceinline__ void p_attention2(Frame& F, char* lds) {
    const bf16_t* P = (const bf16_t*)F.wsp(WS_PROJ); bf16_t* OB = (bf16_t*)F.wsp(WS_OB);
    constexpr int TOTAL = NBATCH * 8 * 2 * 8;
    for (int L = blockIdx.x; L < TOTAL; L += F.G) {
        const int k = (L & 255) >> 3, g = (L >> 8) * 16 + (L & 7) * 2 + (k >> 4), sub = k & 15, comp = sub >> 3, y = sub & 7;
        const int b = g >> 3, h = g & 7; const size_t tok0 = (size_t)b * SEQ;
#pragma unroll 1
        for (int pass = 0; pass < 2; ++pass) { const int qb = pass ? (15 - y) : y;
            att::BlockRef2 r;
            r.Q = P + PLO(COL_Q) + (tok0 + (size_t)qb * att::QB) * PP + h * 256 + comp * 128;
            r.K = P + PLO(COL_K) + tok0 * PP + h * 256 + comp * 128;
            r.V = P + PLO(COL_V) + tok0 * PP + h * 256;
            r.O = OB + (tok0 + (size_t)qb * att::QB) * DM + h * 512 + comp * 256;
            r.P0 = qb * att::QB;
            att::causal_block2(r, lds); }
    }
}

__device__ __forceinline__ void p_post(Frame& F, int l) {
    const int lane = fresh_lane(), gt = F.gw * 64 + lane;
    const bf16_t* P = (const bf16_t*)F.wsp(WS_PROJ); const unsigned* HP = (const unsigned*)F.wsp(WS_HL);
    const float* CIN = (const float*)F.wsp(WS_CIN); const bf16_t* OB = (const bf16_t*)F.wsp(WS_OB); bf16_t* Y = (bf16_t*)F.wsp(WS_Y);
    for (int task0 = gt; task0 < MTOK * (BW / 8); task0 += 4 * F.NGT) {
        u32x4 h0[4], h1[4], sgw[4]; f32x4 c0[4], c1[4];
#pragma unroll
        for (int k = 0; k < 4; ++k) { const int task = task0 + k * F.NGT; if (task < MTOK * (BW / 8)) { const int cg = task & 255, row = task >> 8, ch = cg * 8, chunk = row / CHUNK;
            h0[k] = *(const u32x4*)(HP + (size_t)row * BW + ch); h1[k] = *(const u32x4*)(HP + (size_t)row * BW + ch + 4); sgw[k] = *(const u32x4*)(P + PLO(COL_AG) + (size_t)row * PP + ch);
            c0[k] = *(const f32x4*)(CIN + (size_t)chunk * BW + ch); c1[k] = *(const f32x4*)(CIN + (size_t)chunk * BW + ch + 4); } }
#pragma unroll
        for (int k = 0; k < 4; ++k) { const int task = task0 + k * F.NGT; if (task < MTOK * (BW / 8)) { const int cg = task & 255, row = task >> 8, ch = cg * 8;
            float sg[8], yo[8]; unpack8(sgw[k], sg);
#pragma unroll
            for (int q = 0; q < 8; ++q) sg[q] = fast_silu(sg[q]);
#pragma unroll
            for (int q = 0; q < 4; ++q) { yo[q] = (bf_lo(h0[k][q]) + bf_hi(h0[k][q]) * c0[k][q]) * sg[q]; yo[4 + q] = (bf_lo(h1[k][q]) + bf_hi(h1[k][q]) * c1[k][q]) * sg[4 + q]; }
            *(u32x4*)(Y + (size_t)row * YW + ch) = pack8f(yo); } }
    }
    { const float* ccwp = F.fin(I_CONV_C_W) + (size_t)l * 3 * BW;
      constexpr int RUN = 32, NTASK = (MTOK / RUN) * (BW / 8);
      for (int task = gt; task < NTASK; task += F.NGT) {
        const int cg = task & 255, run = task >> 8, t0 = run * RUN, ch = cg * 8;
        float ccw[3][8];
#pragma unroll
        for (int j = 0; j < 3; ++j) { const f32x4 a = *(const f32x4*)(ccwp + (size_t)j * BW + ch), b = *(const f32x4*)(ccwp + (size_t)j * BW + ch + 4);
#pragma unroll
            for (int q = 0; q < 4; ++q) { ccw[j][q] = a[q]; ccw[j][4 + q] = b[q]; } }
        float p1[8], p2[8];
#pragma unroll
        for (int q = 0; q < 8; ++q) { p1[q] = 0.f; p2[q] = 0.f; }
        if ((t0 & (SEQ - 1)) != 0) {
            const bf16_t* r2 = P + (size_t)(t0 - 2) * PP; const bf16_t* r1 = P + (size_t)(t0 - 1) * PP;
            float c2[8], x2[8], c1[8], x1[8];
            unpack8(*(const u32x4*)(r2 + PLO(COL_CC) + ch), c2); unpack8(*(const u32x4*)(r2 + PLO(COL_CX) + ch), x2); unpack8(*(const u32x4*)(r1 + PLO(COL_CC) + ch), c1); unpack8(*(const u32x4*)(r1 + PLO(COL_CX) + ch), x1);
#pragma unroll
            for (int q = 0; q < 8; ++q) { p2[q] = c2[q] * x2[q]; p1[q] = c1[q] * x1[q]; }
        }
#pragma unroll 4
        for (int r = 0; r < RUN; ++r) { const int t = t0 + r; const bf16_t* rp = P + (size_t)t * PP;
            float cc0[8], cx0[8], cb0[8], cg0[8];
            unpack8(*(const u32x4*)(rp + PLO(COL_CC) + ch), cc0); unpack8(*(const u32x4*)(rp + PLO(COL_CX) + ch), cx0); unpack8(*(const u32x4*)(rp + PLO(COL_CB) + ch), cb0); unpack8(*(const u32x4*)(rp + PLO(COL_CG) + ch), cg0);
            float yo[8];
#pragma unroll
            for (int q = 0; q < 8; ++q) { const float p0 = cc0[q] * cx0[q]; yo[q] = cb0[q] * (ccw[0][q] * p2[q] + ccw[1][q] * p1[q] + ccw[2][q] * p0) * fast_silu(cg0[q]); p2[q] = p1[q]; p1[q] = p0; }
            *(u32x4*)(Y + (size_t)t * YW + 2 * BW + ch) = pack8f(yo); }
      }
    }
    const float lam_init = 0.8f - 0.6f * expf(-0.3f * (float)l);
    const float* lq1 = F.fin(I_LQ1) + l * 128; const float* lk1 = F.fin(I_LK1) + l * 128; const float* lq2 = F.fin(I_LQ2) + l * 128; const float* lk2 = F.fin(I_LK2) + l * 128;
    float s1 = lq1[lane] * lk1[lane] + lq1[64 + lane] * lk1[64 + lane];
    float s2 = lq2[lane] * lk2[lane] + lq2[64 + lane] * lk2[64 + lane];
    s1 = wave_sum(s1); s2 = wave_sum(s2);
    const float lam = expf(s1) - expf(s2) + lam_init;
    const int e = lane * 4;
    const f32x4 sw = *(const f32x4*)(F.fin(I_SUBLN) + l * 256 + e);
    const float post = 1.0f - lam_init;
    for (int row = F.gwo(); row < MTOK; row += F.NGW) {
        u32x2 w0[8], w1[8], wg[8];
#pragma unroll
        for (int h = 0; h < 8; ++h) { w0[h] = *(const u32x2*)(OB + (size_t)row * DM + h * 512 + e); w1[h] = *(const u32x2*)(OB + (size_t)row * DM + h * 512 + 256 + e);
            wg[h] = *(const u32x2*)(P + PLO(COL_BG) + (size_t)row * PP + h * 256 + e); }
        f32x4 d[8]; float ss[8];
#pragma unroll
        for (int h = 0; h < 8; ++h) { d[h].x = bf_lo(w0[h].x) - lam * bf_lo(w1[h].x); d[h].y = bf_hi(w0[h].x) - lam * bf_hi(w1[h].x); d[h].z = bf_lo(w0[h].y) - lam * bf_lo(w1[h].y); d[h].w = bf_hi(w0[h].y) - lam * bf_hi(w1[h].y);
            ss[h] = (d[h].x * d[h].x + d[h].y * d[h].y) + (d[h].z * d[h].z + d[h].w * d[h].w); }
#pragma unroll
        for (int o = 1; o < 64; o <<= 1) {
#pragma unroll
            for (int h = 0; h < 8; ++h) ss[h] += __shfl_xor(ss[h], o); }
#pragma unroll
        for (int h = 0; h < 8; ++h) { const float rs = post * __builtin_amdgcn_rsqf(ss[h] * (1.0f / 256.0f) + 1e-5f);
            u32x2 o; o.x = cvt_pk_bf16(d[h].x * rs * sw.x * fast_silu(bf_lo(wg[h].x)), d[h].y * rs * sw.y * fast_silu(bf_hi(wg[h].x))); o.y = cvt_pk_bf16(d[h].z * rs * sw.z * fast_silu(bf_lo(wg[h].y)), d[h].w * rs * sw.w * fast_silu(bf_hi(wg[h].y)));
            *(u32x2*)(Y + (size_t)row * YW + BW + h * 256 + e) = o; }
    }
}

constexpr int NP = 7;
constexpr int N_PHASES = 2 + DEPTH * NP + 1;
struct Args { const void* in[21]; float* out; unsigned char* ws; int ph_lo, ph_hi; };
__global__ void __launch_bounds__(NWAVES * 64, 2) trunk_fwd(Args args) {
    extern __shared__ __attribute__((aligned(16))) unsigned char lds[];
    Frame F;
    F.lds = (LAS unsigned char*)lds;
    const int tid = threadIdx.x; F.wave = __builtin_amdgcn_readfirstlane(tid >> 6);
    F.G = gridDim.x; { const int bx = blockIdx.x; F.vcu = (F.G % 8 == 0) ? (bx % 8) * (F.G / 8) + bx / 8 : bx; }
    F.gw = F.vcu * NWAVES + F.wave; F.NGW = F.G * NWAVES; F.NGT = F.NGW * 64;
    F.ws = args.ws; F.out = args.out;
    F.in = args.in;
    for (int u = tid; u < (LDS_BYTES - LDSCTL_OFF) / 4; u += NWAVES * 64) ((LAS unsigned*)(F.lds + LDSCTL_OFF))[u] = 0u;
    __syncthreads();
    unsigned* ctl = (unsigned*)(args.ws + WS_CTL);
    const int lo = args.ph_lo, hi = args.ph_hi;
    XcdBarrier bar; bar.bar = ctl + CW_BAR; bar.x = 0; bar.st = nullptr;
    if (hi - lo > 1) bar = xcd_barrier_post(ctl + CW_BAR, (volatile LAS unsigned*)(F.lds + MISC_OFF) + 8);
#define IN(k) (lo <= (k) && (k) < hi)
#define SEAM(k) do { if (IN((k) + 1)) { xcd_barrier(bar); if (PH_REP(11) > 1) xcd_barrier(bar); } } while (0)

    if (IN(0)) { if constexpr (PH_ON(0)) for (int rep = 0; rep < PH_REP(0); ++rep) { p_wquant_fused(F); p_prologue(F); } SEAM(0); }

    if (IN(1)) { SEAM(1); }

    for (int l = 0; l < DEPTH; ++l) {
        const int pb = 2 + l * NP;
        if (IN(pb + 0)) { if constexpr (PH_ON(1)) for (int rep = 0; rep < PH_REP(1); ++rep) {
            if (l == 0) p_rmsnorm_bf16<true>(F, F.fin(I_X), F.fin(I_NORM_W), (bf16_t*)F.wsp(WS_H));
            else p_rmsnorm_bf16<false>(F, F.wsp((l & 1) ? WS_XB : WS_XB1), F.fin(I_NORM_W) + (size_t)l * DM, (bf16_t*)F.wsp(WS_H)); }
            SEAM(pb + 0); }
        if (IN(pb + 1)) { if constexpr (PH_ON(2)) for (int rep = 0; rep < PH_REP(2); ++rep) {
            pg8::Gemm g{(const bf16_t*)F.wsp(WS_H), (const bf16_t*)F.wsp(WS_WIN) + (size_t)l * INC * DM, DM, DM, DM}; pg8::Order<4, WG_P> S; S.init(MTOK, NB_TILES * 256, F.G, (int)blockIdx.x);
            pg8::EpiProj E{(bf16_t*)F.wsp(WS_PROJ), F.fin(I_GATE_B) + (size_t)l * 3 * DM, (const int*)F.fin(I_POS), nullptr, nullptr};
            pg8::gemm_phase<pg8::EpiProj, pg8::Order<4, WG_P>>(F.lds + RING_OFF, g, S, E); }
            SEAM(pb + 1);
        }
        if (IN(pb + 2)) { if constexpr (PH_ON(4)) for (int rep = 0; rep < PH_REP(4); ++rep) {
            pg8::Gemm g{(const bf16_t*)F.wsp(WS_HQ), (const bf16_t*)F.wsp(WS_WQ) + (size_t)l * INC * (DM / 2), DM / 2, DM / 2, DM / 2}; pg8::Order<3, WG_Q> S; S.init(MTOK, NQ_TILES * 256, F.G, (int)blockIdx.x);
            pg8::EpiProj E{(bf16_t*)F.wsp(WS_PROJ), F.fin(I_GATE_B) + (size_t)l * 3 * DM, (const int*)F.fin(I_POS), (const float*)F.wsp(WS_SA), (const float*)F.wsp(WS_SW) + (size_t)l * INC};
            pg8::gemm_phase<pg8::EpiProj, pg8::Order<3, WG_Q>, true, true, true>(F.lds + RING_OFF, g, S, E); }
            if constexpr (PH_ON(3)) for (int rep = 0; rep < PH_REP(3); ++rep) p_lru(F, l);
            SEAM(pb + 2);
        }
        if (IN(pb + 3)) { if constexpr (PH_ON(6)) for (int rep = 0; rep < PH_REP(6); ++rep) { p_carry(F); p_attention2(F, (char*)lds + RING_OFF); } SEAM(pb + 3); }
        if (IN(pb + 4)) { if constexpr (PH_ON(7)) for (int rep = 0; rep < PH_REP(7); ++rep) p_post(F, l); SEAM(pb + 4); }
        if (IN(pb + 5)) { if constexpr (PH_ON(8)) for (int rep = 0; rep < PH_REP(8); ++rep) {
            pg8::Gemm g{(const bf16_t*)F.wsp(WS_Y), (const bf16_t*)F.wsp(WS_WB) + (size_t)l * DM * YW, YW, YW, BW}; pg8::Order<2, WG_B> S; S.init(MTOK, DM, F.G, (int)blockIdx.x);
            pg8::EpiMerge E{(bf16_t*)F.wsp(WS_MG), (const bf16_t*)F.wsp(WS_PROJ)};
            pg8::gemm_phase<pg8::EpiMerge, pg8::Order<2, WG_B>>(F.lds + RING_OFF, g, S, E); }
            SEAM(pb + 5);
        }
        if (IN(pb + 6)) { if constexpr (PH_ON(9)) for (int rep = 0; rep < PH_REP(9); ++rep) {
            pg8::Gemm g{(const bf16_t*)F.wsp(WS_MG), (const bf16_t*)F.wsp(WS_WO) + (size_t)l * DM * DM, DM, DM, DM}; pg8::Order<0, WG_O> S; S.init(MTOK, DM, F.G, (int)blockIdx.x);
            if (l == 0) { pg8::EpiOut<true> E{F.fin(I_X), (bf16_t*)F.wsp(WS_XB)}; pg8::gemm_phase<pg8::EpiOut<true>, pg8::Order<0, WG_O>>(F.lds + RING_OFF, g, S, E); }
            else { pg8::EpiOut<false> E{F.wsp((l & 1) ? WS_XB : WS_XB1), (bf16_t*)F.wsp((l & 1) ? WS_XB1 : WS_XB)}; pg8::gemm_phase<pg8::EpiOut<false>, pg8::Order<0, WG_O>>(F.lds + RING_OFF, g, S, E); } }
            SEAM(pb + 6);
        }
    }
    if (IN(N_PHASES - 1)) { if constexpr (PH_ON(10)) p_rmsnorm_f32(F, (const bf16_t*)F.wsp(((DEPTH - 1) & 1) ? WS_XB1 : WS_XB), F.fin(I_FINAL_W), F.out); }
#undef IN
#undef SEAM
}

extern "C" void kernel_launch(void* const* d_in, const int* in_sizes, int n_in, void* d_out, int out_size, void* d_ws, size_t ws_size, hipStream_t stream) {
    static int grid = 0;
    if (grid == 0) {
        if (n_in != 21 || in_sizes[0] != MTOK * DM || out_size != MTOK * DM || ws_size < WS_END) { fprintf(stderr, "kernel_launch: unexpected shapes (n_in %d, in0 %d, out %d, ws %zu)\n", n_in, n_in > 0 ? in_sizes[0] : -1, out_size, ws_size); grid = -1; return; }
        int dev = 0, cus = 0, per_cu = 0;
        if (hipGetDevice(&dev) != hipSuccess || hipDeviceGetAttribute(&cus, hipDeviceAttributeMultiprocessorCount, dev) != hipSuccess) { grid = -1; return; }
        if (hipFuncSetAttribute((const void*)trunk_fwd, hipFuncAttributeMaxDynamicSharedMemorySize, LDS_BYTES) != hipSuccess) { fprintf(stderr, "kernel_launch: hipFuncSetAttribute failed\n"); grid = -1; return; }
        if (hipOccupancyMaxActiveBlocksPerMultiprocessor(&per_cu, (const void*)trunk_fwd, NWAVES * 64, LDS_BYTES) != hipSuccess || per_cu < 1) fprintf(stderr, "kernel_launch: occupancy query reports %d\n", per_cu);
        (void)hipGetLastError();
        grid = cus;
    }
    if (grid < 0) return;
    if (hipMemsetAsync((char*)d_ws + WS_CTL, 0, CTL_ZERO_BYTES, stream) != hipSuccess) return;
    Args a{};
    for (int i = 0; i < 21; ++i) a.in[i] = d_in[i];
    a.out = (float*)d_out; a.ws = (unsigned char*)d_ws;
#if MK_N_LAUNCHES == 1
    a.ph_lo = 0; a.ph_hi = N_PHASES;
    hipLaunchKernelGGL(trunk_fwd, dim3(grid), dim3(NWAVES * 64), LDS_BYTES, stream, a);
#else
    for (int p = 0; p < N_PHASES; ++p) { a.ph_lo = p; a.ph_hi = p + 1; hipLaunchKernelGGL(trunk_fwd, dim3(grid), dim3(NWAVES * 64), LDS_BYTES, stream, a); }
#endif
}
```
